# Optimizing an MI355X kernel written in HIP

```python
import math
import jax, jax.numpy as jnp
from jax import lax
import numpy as np


D_MODEL = 4096
BATCH = 1
SEQ = 8192
DEPTH = 2

CHUNK = 64
N_A_LAYERS = DEPTH // 2
N_B_LAYERS = DEPTH - N_A_LAYERS
POOL_EXPAND = 2
POOL_WIDTH = POOL_EXPAND * D_MODEL
POOL_WINDOWS = (2, 4, 8, 16)
N_POOL_GROUPS = len(POOL_WINDOWS)
POOL_GROUP = POOL_WIDTH // N_POOL_GROUPS
DIFF_HEAD_DIM = 128
N_DIFF_HEADS = D_MODEL // (2 * DIFF_HEAD_DIM)
ATT_WIDTH = N_DIFF_HEADS * 2 * DIFF_HEAD_DIM
ROPE_THETA = 10000.0
Q_BLOCK = 128
EPS = 1e-6

kernel_name = "yoco_pool_diffattn_hybrid"


def rms_norm(x, g):
    xf = x.astype(jnp.float32)
    y = xf * lax.rsqrt(jnp.mean(xf * xf, axis=-1, keepdims=True) + EPS)
    return (y * g.astype(jnp.float32)).astype(x.dtype)


def ada_mod(c, w, b, n):
    m = jnp.einsum('bd,de->be', jax.nn.silu(c), w) + b
    return jnp.split(m[:, None, :], n, axis=-1)


def rotary(x, positions):
    dh = x.shape[-1]
    half = dh // 2
    inv = ROPE_THETA ** (-jnp.arange(0, dh, 2, dtype=jnp.float32) / dh)
    ang = positions.astype(jnp.float32)[..., None] * inv
    cos = jnp.cos(ang)[:, :, None, :]
    sin = jnp.sin(ang)[:, :, None, :]
    xf = x.astype(jnp.float32)
    x1, x2 = xf[..., :half], xf[..., half:]
    out = jnp.concatenate([x1 * cos - x2 * sin, x2 * cos + x1 * sin], axis=-1)
    return out.astype(x.dtype)


def pool_mixer(u, w_group, scale):
    B, S, _ = u.shape
    t = jnp.arange(S)
    ug = u.astype(jnp.float32).reshape(B, S, N_POOL_GROUPS, POOL_GROUP)
    cs = jnp.cumsum(ug, axis=1)
    outs = []
    for g, w in enumerate(POOL_WINDOWS):
        csg = cs[:, :, g]
        prev = jnp.pad(csg, ((0, 0), (w, 0), (0, 0)))[:, :S]
        cnt = jnp.minimum(t + 1, w).astype(jnp.float32)[None, :, None]
        outs.append((csg - prev) / cnt - ug[:, :, g])
    pooled = jnp.stack(outs, axis=2).astype(u.dtype)
    mixed = jnp.einsum('bsgc,gce->bsge', pooled, w_group)
    return mixed.reshape(B, S, POOL_WIDTH) * scale


def diff_attention(q, k, v, lam):
    B, S, H, _, dh = q.shape
    nb = S // Q_BLOCK
    qb = q.reshape(B, nb, Q_BLOCK, H, 2, dh).transpose(1, 0, 3, 4, 2, 5)
    kt = k.transpose(0, 2, 3, 1, 4)
    vt = v.transpose(0, 2, 1, 3)
    key_chunk = jnp.arange(S) // CHUNK
    sm_scale = dh ** -0.5

    def block(args):
        q_blk, i = args
        s = jnp.einsum('bhcqd,bhckd->bhcqk', q_blk, kt).astype(jnp.float32) * sm_scale
        q_chunk = (i * Q_BLOCK + jnp.arange(Q_BLOCK)) // CHUNK
        mask = key_chunk[None, :] <= q_chunk[:, None]
        s = jnp.where(mask, s, -jnp.inf)
        p = jax.nn.softmax(s, axis=-1)
        pd = p[:, :, 0] - lam * p[:, :, 1]
        return jnp.einsum('bhqk,bhkd->bhqd', pd.astype(v.dtype), vt)

    o = lax.map(block, (qb, jnp.arange(nb)))
    return o.transpose(1, 0, 3, 2, 4).reshape(B, S, H, 2 * dh)


def setup_inputs(seed: int = 0) -> dict:
    key = jax.random.key(seed)
    ks = jax.random.split(key, 24)
    D = D_MODEL
    f32 = jnp.float32

    def nrm(k, shape, fan_in, mult=1.0):
        return jax.random.normal(k, shape, f32) * (mult * fan_in ** -0.5)

    def gain(k, shape):
        return 1.0 + 0.02 * jax.random.normal(k, shape, f32)

    def bias(k, shape):
        return 0.02 * jax.random.normal(k, shape, f32)

    x = jax.random.normal(ks[0], (BATCH, SEQ, D), f32)
    c = jax.random.normal(ks[1], (BATCH, D), f32)
    positions = jnp.broadcast_to(jnp.arange(SEQ, dtype=jnp.int32)[None, :], (BATCH, SEQ))
    nA, nB = N_A_LAYERS, N_B_LAYERS
    return {
        'x': x,
        'c': c,
        'positions': positions,
        'a_norm_g': gain(ks[2], (nA, D)),
        'a_ada_w': nrm(ks[3], (nA, D, 3 * D), D, 0.5),
        'a_ada_b': bias(ks[4], (nA, 3 * D)),
        'a_w_in': nrm(ks[5], (nA, D, 2 * POOL_WIDTH), D),
        'a_w_group': nrm(ks[6], (nA, N_POOL_GROUPS, POOL_GROUP, POOL_GROUP), POOL_GROUP),
        'a_scale': gain(ks[7], (nA, POOL_WIDTH)),
        'a_w_out': nrm(ks[8], (nA, POOL_WIDTH, D), POOL_WIDTH),
        'kv_norm_g': gain(ks[9], (D,)),
        'kv_ada_w': nrm(ks[10], (D, 2 * D), D, 0.5),
        'kv_ada_b': bias(ks[11], (2 * D,)),
        'w_kv': nrm(ks[12], (D, 2 * ATT_WIDTH), D),
        'b_norm_g': gain(ks[13], (nB, D)),
        'b_ada_w': nrm(ks[14], (nB, D, 3 * D), D, 0.5),
        'b_ada_b': bias(ks[15], (nB, 3 * D)),
        'b_w_qg': nrm(ks[16], (nB, D, 2 * ATT_WIDTH), D),
        'b_lam': 0.1 * jax.random.normal(ks[17], (nB, 4, DIFF_HEAD_DIM), f32),
        'b_subln_g': gain(ks[18], (nB, 2 * DIFF_HEAD_DIM)),
        'b_w_out': nrm(ks[19], (nB, ATT_WIDTH, D), ATT_WIDTH),
        'final_g': gain(ks[20], (D,)),
    }


def reference(x, c, positions, a_norm_g, a_ada_w, a_ada_b, a_w_in, a_w_group, a_scale, a_w_out,
              kv_norm_g, kv_ada_w, kv_ada_b, w_kv,
              b_norm_g, b_ada_w, b_ada_b, b_w_qg, b_lam, b_subln_g, b_w_out, final_g):
    B, S, _ = x.shape
    H, dh = N_DIFF_HEADS, DIFF_HEAD_DIM
    h = x
    k_shared = None
    v_shared = None
    for l in range(DEPTH):
        if l < N_A_LAYERS:
            i = l
            shift, scale, gate = ada_mod(c, a_ada_w[i], a_ada_b[i], 3)
            hn = rms_norm(h, a_norm_g[i]) * (1 + scale) + shift
            u, z = jnp.split(hn @ a_w_in[i], 2, axis=-1)
            y = pool_mixer(u, a_w_group[i], a_scale[i]) * jax.nn.silu(z)
            h = h + gate * (y @ a_w_out[i])
        else:
            j = l - N_A_LAYERS
            if j == 0:
                kv_shift, kv_scale = ada_mod(c, kv_ada_w, kv_ada_b, 2)
                kvn = rms_norm(h, kv_norm_g) * (1 + kv_scale) + kv_shift
                k_flat, v_flat = jnp.split(kvn @ w_kv, 2, axis=-1)
                k_shared = rotary(k_flat.reshape(B, S, 2 * H, dh), positions).reshape(B, S, H, 2, dh)
                v_shared = v_flat.reshape(B, S, H, 2 * dh)
            shift, scale, gate = ada_mod(c, b_ada_w[j], b_ada_b[j], 3)
            hn = rms_norm(h, b_norm_g[j]) * (1 + scale) + shift
            q_flat, z = jnp.split(hn @ b_w_qg[j], 2, axis=-1)
            q = rotary(q_flat.reshape(B, S, 2 * H, dh), positions).reshape(B, S, H, 2, dh)
            lp = b_lam[j].astype(jnp.float32)
            lam_init = 0.8 - 0.6 * math.exp(-0.3 * l)
            lam = jnp.exp(jnp.sum(lp[0] * lp[1])) - jnp.exp(jnp.sum(lp[2] * lp[3])) + lam_init
            o = diff_attention(q, k_shared, v_shared, lam)
            o = rms_norm(o, b_subln_g[j]) * (1.0 - lam_init)
            y = o.reshape(B, S, ATT_WIDTH) * jax.nn.silu(z)
            h = h + gate * (y @ b_w_out[j])
    return rms_norm(h, final_g)
```

```cpp
#include <hip/hip_runtime.h>
#include <hip/hip_bf16.h>
#include <cstdio>
#include <cstdint>
#include <cmath>

#ifndef MK_N_LAUNCHES
#define MK_N_LAUNCHES 1
#endif
constexpr int N_PHASES = 12;
constexpr int N_LAUNCHES = MK_N_LAUNCHES;

namespace pg8 {
#define PG8_LAS __attribute__((address_space(3)))
typedef unsigned short bf16_t;
typedef short bf16x8 __attribute__((ext_vector_type(8)));
typedef float f32x4 __attribute__((ext_vector_type(4)));
typedef float f32x2 __attribute__((ext_vector_type(2)));
typedef unsigned u32x4 __attribute__((ext_vector_type(4)));
constexpr int BM = 256, BK = 64, HALF = 128, HTB = HALF * BK * 2, STAGE_BYTES = 8 * HTB, NXCD = 8, WGM = 8;

__host__ __device__ __forceinline__ int lds_byte(int r, int c) { const int st = (r >> 4) * 2 + (c >> 5), rr = r & 15, cc = c & 31, ob = rr * 64 + cc * 2; return st * 1024 + (ob ^ (((ob >> 9) & 1) << 5)); }
__host__ __device__ __forceinline__ void stage_rc(int b, int& R, int& C) { const int st = b / 1024, sb = b % 1024, swz = sb ^ (((sb >> 9) & 1) << 5); R = (st >> 1) * 16 + swz / 64; C = (st & 1) * 32 + (swz % 64) / 2; }
__host__ __device__ __forceinline__ int perm32(int rho) { const int n = rho >> 4, i = rho & 15; return 8 * (i >> 2) + 4 * n + (i & 3); }

struct Unit { int pm, pn; };
struct Gemm { const bf16_t* A; const bf16_t* Bt; int M, N, K, lda, ldb, adiv; long astride; };

struct StaticOrder {
    int nM, nN, nwg, G, c;
    __host__ __device__ void init(int M, int N, int G_, int c_) { nM = M / BM; nN = N / BM; nwg = nM * nN; G = G_; c = c_; }
    __host__ __device__ bool next(int i, Unit& u) const {
        const long L = (long)i * G + c; if (L >= nwg) return false;
        int wgid = (int)L; { const int q = nwg / NXCD, r = nwg % NXCD, xcd = wgid % NXCD, off = wgid / NXCD; wgid = (xcd < r ? xcd * (q + 1) : r * (q + 1) + (xcd - r) * q) + off; }
        const int nig = WGM * nN, gid = wgid / nig, fm = gid * WGM, gsz = (nM - fm) < WGM ? (nM - fm) : WGM;
        u.pm = fm + ((wgid % nig) % gsz); u.pn = (wgid % nig) / gsz; return true;
    }
    __device__ __forceinline__ void a_ready(const Unit&) const {}
    __device__ __forceinline__ void done(const Unit&) const {}
};

__device__ __forceinline__ unsigned cvt_pk_bf16(float lo, float hi) { unsigned r; asm volatile("v_cvt_pk_bf16_f32 %0, %1, %2" : "=v"(r) : "v"(lo), "v"(hi)); return r; }
__device__ __forceinline__ float bf_lo(unsigned u) { return __uint_as_float(u << 16); }
__device__ __forceinline__ float bf_hi(unsigned u) { return __uint_as_float(u & 0xffff0000u); }
__device__ __forceinline__ float silu_f(float z) { return z * __builtin_amdgcn_rcpf(1.0f + __builtin_amdgcn_exp2f(-1.4426950408889634f * z)); }


struct EpiBf16 {
    static constexpr bool PERM = true;
    bf16_t* O; int ldc;
    __device__ __forceinline__ void operator()(const f32x4 (&acc)[2][2][4][2], const Unit& u, int wr, int wc, int fr, int fq) const {
        const int row0 = u.pm * BM + wr * 64 + fr, col0 = u.pn * BM + wc * 32 + 8 * fq;
#pragma unroll
        for (int ai = 0; ai < 2; ++ai)
#pragma unroll
            for (int m = 0; m < 4; ++m) { bf16_t* rowp = O + (size_t)(row0 + ai * HALF + m * 16) * ldc + col0;
#pragma unroll
                for (int bj = 0; bj < 2; ++bj) { const f32x4 v0 = acc[ai][bj][m][0], v1 = acc[ai][bj][m][1];
                    u32x4 w; w.x = cvt_pk_bf16(v0[0], v0[1]); w.y = cvt_pk_bf16(v0[2], v0[3]); w.z = cvt_pk_bf16(v1[0], v1[1]); w.w = cvt_pk_bf16(v1[2], v1[3]);
                    *(u32x4*)(rowp + bj * HALF) = w; } }
    }
};
struct EpiPoolY {
    static constexpr bool PERM = true;
    bf16_t* O; int ldc; const float* cscale; const bf16_t* Z; int ldz;
    __device__ __forceinline__ void operator()(const f32x4 (&acc)[2][2][4][2], const Unit& u, int wr, int wc, int fr, int fq) const {
        const int row0 = u.pm * BM + wr * 64 + fr, col0 = u.pn * BM + wc * 32 + 8 * fq;
        f32x4 sv[2][2];
#pragma unroll
        for (int bj = 0; bj < 2; ++bj)
#pragma unroll
            for (int n = 0; n < 2; ++n) sv[bj][n] = *(const f32x4*)(cscale + col0 + bj * HALF + 4 * n);
#pragma unroll
        for (int ai = 0; ai < 2; ++ai)
#pragma unroll
            for (int m = 0; m < 4; ++m) { const size_t r = (size_t)(row0 + ai * HALF + m * 16); bf16_t* rowp = O + r * ldc + col0; const bf16_t* zp = Z + r * ldz + col0;
#pragma unroll
                for (int bj = 0; bj < 2; ++bj) { const u32x4 zz = *(const u32x4*)(zp + bj * HALF);
                    const f32x4 v0 = acc[ai][bj][m][0] * sv[bj][0], v1 = acc[ai][bj][m][1] * sv[bj][1];
                    u32x4 w;
                    w.x = cvt_pk_bf16(v0[0] * silu_f(bf_lo(zz.x)), v0[1] * silu_f(bf_hi(zz.x)));
                    w.y = cvt_pk_bf16(v0[2] * silu_f(bf_lo(zz.y)), v0[3] * silu_f(bf_hi(zz.y)));
                    w.z = cvt_pk_bf16(v1[0] * silu_f(bf_lo(zz.z)), v1[1] * silu_f(bf_hi(zz.z)));
                    w.w = cvt_pk_bf16(v1[2] * silu_f(bf_lo(zz.w)), v1[3] * silu_f(bf_hi(zz.w)));
                    *(u32x4*)(rowp + bj * HALF) = w; } }
    }
};
struct EpiResid {
    static constexpr bool PERM = false;
    const float* base; float* out; int ldc; const float* gate;
    __device__ __forceinline__ void operator()(const f32x4 (&acc)[2][2][4][2], const Unit& u, int wr, int wc, int fr, int fq) const {
        const int row0 = u.pm * BM + wr * 64 + fr, col0 = u.pn * BM + wc * 32 + 4 * fq;
        f32x4 gv[2][2];
#pragma unroll
        for (int bj = 0; bj < 2; ++bj)
#pragma unroll
            for (int n = 0; n < 2; ++n) gv[bj][n] = *(const f32x4*)(gate + col0 + bj * HALF + n * 16);
#pragma unroll
        for (int ai = 0; ai < 2; ++ai)
#pragma unroll
            for (int m = 0; m < 4; ++m) { const size_t off = (size_t)(row0 + ai * HALF + m * 16) * ldc + col0;
#pragma unroll
                for (int bj = 0; bj < 2; ++bj)
#pragma unroll
                    for (int n = 0; n < 2; ++n) { const f32x4 b = *(const f32x4*)(base + off + bj * HALF + n * 16);
                        *(f32x4*)(out + off + bj * HALF + n * 16) = b + gv[bj][n] * acc[ai][bj][m][n]; } }
    }
};
struct EpiKVQZ {
    static constexpr bool PERM = true;
    bf16_t* O; size_t tstride; const float* cs; const float* sn;
    __device__ __forceinline__ void operator()(const f32x4 (&acc)[2][2][4][2], const Unit& u, int wr, int wc, int fr, int fq) const {
        const int t = u.pn >> 4; const bool rot = (t == 0) || (t == 2);
        const int row0 = u.pm * BM + wr * 64 + fr, col0 = (u.pn & 15) * BM + wc * 32 + 8 * fq, i0 = wc * 16 + 4 * fq;
        bf16_t* base = O + (size_t)t * tstride;
#pragma unroll
        for (int ai = 0; ai < 2; ++ai)
#pragma unroll
            for (int m = 0; m < 4; ++m) { const int row = row0 + ai * HALF + m * 16; bf16_t* rowp = base + (size_t)row * 4096 + col0;
                f32x4 c4 = (f32x4){1.f, 1.f, 1.f, 1.f}, s4 = (f32x4){0.f, 0.f, 0.f, 0.f};
                if (rot) { c4 = *(const f32x4*)(cs + (size_t)row * 64 + i0); s4 = *(const f32x4*)(sn + (size_t)row * 64 + i0); }
#pragma unroll
                for (int bj = 0; bj < 2; ++bj) { const f32x4 v0 = acc[ai][bj][m][0], v1 = acc[ai][bj][m][1];
                    u32x4 w;
                    w.x = cvt_pk_bf16(v0[0] * c4[0] - v0[1] * s4[0], v0[1] * c4[0] + v0[0] * s4[0]);
                    w.y = cvt_pk_bf16(v0[2] * c4[1] - v0[3] * s4[1], v0[3] * c4[1] + v0[2] * s4[1]);
                    w.z = cvt_pk_bf16(v1[0] * c4[2] - v1[1] * s4[2], v1[1] * c4[2] + v1[0] * s4[2]);
                    w.w = cvt_pk_bf16(v1[2] * c4[3] - v1[3] * s4[3], v1[3] * c4[3] + v1[2] * s4[3]);
                    *(u32x4*)(rowp + bj * HALF) = w; } }
    }
};

template <class Epi, class Sched, bool ALIGN_EPI = false, bool SP2 = false>
__device__ __forceinline__ void gemm_phase(PG8_LAS unsigned char* lds, const Gemm g, const Sched& S, const Epi& E) {
    const int tid = threadIdx.x, wid = __builtin_amdgcn_readfirstlane(tid >> 6), lane = tid & 63, wr = wid >> 2, wc = wid & 3, fr = lane & 15, fq = lane >> 4;
    const int K = g.K, nt = K / BK;
    unsigned voffA[2], voffB[2];
#pragma unroll
    for (int i = 0; i < 2; ++i) { int R, C; stage_rc(tid * 16 + i * 8192, R, C); const int Rb = Epi::PERM ? ((R & ~31) + perm32(R & 31)) : R;
        voffA[i] = (unsigned)(R * g.lda + C) * 2u; voffB[i] = (unsigned)(Rb * g.ldb + C) * 2u; }
    const size_t kstep = (size_t)(BK * 2);
    const size_t hstepA = (size_t)HALF * g.lda * 2, hstepB = (size_t)HALF * g.ldb * 2;
    const unsigned ldsw = (unsigned)wid * 1024u;
    const int aoff = lds_byte(wr * 64 + fr, fq * 8), boff = lds_byte(wc * 32 + fr, fq * 8);
#define PG8_UA(u) ((const char*)g.A + (size_t)(u).pm * 2 * hstepA + (size_t)((u).pn / g.adiv) * (size_t)g.astride)
#define PG8_UB(u) ((const char*)g.Bt + (size_t)(u).pn * 2 * hstepB)
#define PG8_SA(b, h) (((b) * 2 + (h)) * HTB)
#define PG8_SB(b, h) ((4 + (b) * 2 + (h)) * HTB)
#define PG8_STAGE(bufoff, gbase, voff) do { _Pragma("unroll") for (int _i = 0; _i < 2; ++_i) \
        __builtin_amdgcn_global_load_lds((const unsigned*)((const char*)(gbase) + (voff)[_i]), (PG8_LAS unsigned*)(lds + (bufoff) + ldsw + _i * 8192), 16, 0, 0); } while (0)
#define PG8_LDA(dst, b, h) do { _Pragma("unroll") for (int m = 0; m < 4; ++m) _Pragma("unroll") for (int k = 0; k < 2; ++k) dst[m][k] = *(const PG8_LAS bf16x8*)(lds + PG8_SA(b, h) + aoff + m * 2048 + k * 1024); } while (0)
#define PG8_LDB(dst, b, h) do { _Pragma("unroll") for (int n = 0; n < 2; ++n) _Pragma("unroll") for (int k = 0; k < 2; ++k) dst[n][k] = *(const PG8_LAS bf16x8*)(lds + PG8_SB(b, h) + boff + n * 2048 + k * 1024); } while (0)
#define PG8_MMA(ai, bj, At, Bt) do { __builtin_amdgcn_s_setprio(1); _Pragma("unroll") for (int m = 0; m < 4; ++m) _Pragma("unroll") for (int n = 0; n < 2; ++n) _Pragma("unroll") for (int k = 0; k < 2; ++k) \
        acc[ai][bj][m][n] = __builtin_amdgcn_mfma_f32_16x16x32_bf16(Bt[n][k], At[m][k], acc[ai][bj][m][n], 0, 0, 0); __builtin_amdgcn_s_setprio(0); } while (0)
#define PG8_WAIT_V(n) asm volatile("s_waitcnt vmcnt(" #n ")" ::: "memory")
#define PG8_WAIT_L(n) asm volatile("s_waitcnt lgkmcnt(" #n ")" ::: "memory")
#define PG8_BAR __builtin_amdgcn_s_barrier()
#define PG8_SCHED __builtin_amdgcn_sched_barrier(0)
    Unit cur, nxt; int ui = 0;
    if (!S.next(0, cur)) return;
    f32x4 acc[2][2][4][2];
#pragma unroll
    for (int a = 0; a < 2; ++a)
#pragma unroll
        for (int b = 0; b < 2; ++b)
#pragma unroll
            for (int m = 0; m < 4; ++m)
#pragma unroll
                for (int n = 0; n < 2; ++n) acc[a][b][m][n] = (f32x4){0.f, 0.f, 0.f, 0.f};
    bf16x8 At[4][2], B0[2][2], B1[2][2];
    const char* cA = PG8_UA(cur); const char* cB = PG8_UB(cur);
    S.a_ready(cur);
    if constexpr (SP2) {
        PG8_STAGE(PG8_SB(0, 0), cB, voffB); PG8_STAGE(PG8_SB(0, 1), cB + hstepB, voffB); PG8_STAGE(PG8_SA(0, 0), cA, voffA); PG8_STAGE(PG8_SA(0, 1), cA + hstepA, voffA);
        if (wr == 1) PG8_BAR;
        PG8_WAIT_V(2); PG8_BAR;
        PG8_STAGE(PG8_SB(1, 0), cB + kstep, voffB); PG8_STAGE(PG8_SA(1, 0), cA + kstep, voffA); PG8_STAGE(PG8_SB(1, 1), cB + hstepB + kstep, voffB);
        PG8_WAIT_V(6); PG8_BAR;
    } else {
        PG8_STAGE(PG8_SB(0, 0), cB, voffB); PG8_STAGE(PG8_SA(0, 0), cA, voffA); PG8_STAGE(PG8_SB(0, 1), cB + hstepB, voffB); PG8_STAGE(PG8_SA(0, 1), cA + hstepA, voffA);
        if (wr == 1) PG8_BAR;
        PG8_WAIT_V(4); PG8_BAR;
        PG8_STAGE(PG8_SB(1, 0), cB + kstep, voffB); PG8_STAGE(PG8_SA(1, 0), cA + kstep, voffA); PG8_STAGE(PG8_SB(1, 1), cB + hstepB + kstep, voffB);
        PG8_WAIT_V(6); PG8_BAR;
    }
    for (;;) {
        const bool has_next = S.next(ui + 1, nxt);
        const char* nA = has_next ? PG8_UA(nxt) : cA; const char* nB = has_next ? PG8_UB(nxt) : cB;
        for (int t = 0; t < nt; t += 2) {
            const bool last = (t == nt - 2);
            const char* a1 = cA + (size_t)(t + 1) * kstep;
            const char* a2 = last ? nA : cA + (size_t)(t + 2) * kstep; const char* b2 = last ? nB : cB + (size_t)(t + 2) * kstep;
            const char* a3 = a2 + kstep; const char* b3 = b2 + kstep;
            if (last && has_next) S.a_ready(nxt);
            if constexpr (SP2) {
            PG8_LDB(B0, 0, 0); PG8_LDB(B1, 0, 1); PG8_SCHED; PG8_LDA(At, 0, 0); PG8_STAGE(PG8_SA(1, 1), a1 + hstepA, voffA);
            PG8_WAIT_V(8); PG8_WAIT_L(0); PG8_BAR; PG8_MMA(0, 0, At, B0); PG8_MMA(0, 1, At, B1); PG8_BAR; PG8_SCHED;
            PG8_LDA(At, 0, 1); PG8_STAGE(PG8_SB(0, 0), b2, voffB); PG8_STAGE(PG8_SB(0, 1), b2 + hstepB, voffB); PG8_STAGE(PG8_SA(0, 0), a2, voffA);
            PG8_WAIT_V(8); PG8_WAIT_L(0); PG8_BAR; PG8_MMA(1, 0, At, B0); PG8_MMA(1, 1, At, B1); PG8_BAR; PG8_SCHED;
            PG8_LDB(B0, 1, 0); PG8_LDB(B1, 1, 1); PG8_SCHED; PG8_LDA(At, 1, 0); PG8_STAGE(PG8_SA(0, 1), a2 + hstepA, voffA);
            PG8_WAIT_V(8); PG8_WAIT_L(0); PG8_BAR; PG8_MMA(0, 0, At, B0); PG8_MMA(0, 1, At, B1); PG8_BAR; PG8_SCHED;
            PG8_LDA(At, 1, 1); PG8_STAGE(PG8_SB(1, 0), b3, voffB); PG8_STAGE(PG8_SB(1, 1), b3 + hstepB, voffB); PG8_STAGE(PG8_SA(1, 0), a3, voffA);
            PG8_WAIT_V(8); PG8_WAIT_L(0); PG8_BAR; PG8_MMA(1, 0, At, B0); PG8_MMA(1, 1, At, B1); PG8_BAR; PG8_SCHED;
            } else {
            PG8_LDB(B0, 0, 0); PG8_SCHED; PG8_LDA(At, 0, 0); PG8_STAGE(PG8_SA(1, 1), a1 + hstepA, voffA);
            PG8_WAIT_L(8); PG8_BAR; PG8_WAIT_L(0); PG8_MMA(0, 0, At, B0); PG8_BAR; PG8_SCHED;
            PG8_LDB(B1, 0, 1); PG8_STAGE(PG8_SB(0, 0), b2, voffB);
            PG8_BAR; PG8_WAIT_L(0); PG8_MMA(0, 1, At, B1); PG8_BAR;
            PG8_LDA(At, 0, 1); PG8_STAGE(PG8_SA(0, 0), a2, voffA);
            PG8_BAR; PG8_WAIT_L(0); PG8_MMA(1, 0, At, B0); PG8_BAR; PG8_SCHED;
            PG8_STAGE(PG8_SB(0, 1), b2 + hstepB, voffB);
            PG8_WAIT_V(6); PG8_BAR; PG8_MMA(1, 1, At, B1); PG8_BAR;
            PG8_LDB(B0, 1, 0); PG8_SCHED; PG8_LDA(At, 1, 0); PG8_STAGE(PG8_SA(0, 1), a2 + hstepA, voffA);
            PG8_WAIT_L(8); PG8_BAR; PG8_WAIT_L(0); PG8_MMA(0, 0, At, B0); PG8_BAR; PG8_SCHED;
            PG8_LDB(B1, 1, 1); PG8_STAGE(PG8_SB(1, 0), b3, voffB);
            PG8_BAR; PG8_WAIT_L(0); PG8_MMA(0, 1, At, B1); PG8_BAR;
            PG8_LDA(At, 1, 1); PG8_STAGE(PG8_SA(1, 0), a3, voffA);
            PG8_BAR; PG8_WAIT_L(0); PG8_MMA(1, 0, At, B0); PG8_BAR; PG8_SCHED;
            PG8_STAGE(PG8_SB(1, 1), b3 + hstepB, voffB);
            PG8_WAIT_V(6); PG8_BAR; PG8_MMA(1, 1, At, B1); PG8_BAR;
            }
        }
        if constexpr (ALIGN_EPI) { if (wr == 0) PG8_BAR; }
        E(acc, cur, wr, wc, fr, fq); S.done(cur);
        if (!has_next) break;
#pragma unroll
        for (int a = 0; a < 2; ++a)
#pragma unroll
            for (int b = 0; b < 2; ++b)
#pragma unroll
                for (int m = 0; m < 4; ++m)
#pragma unroll
                    for (int n = 0; n < 2; ++n) acc[a][b][m][n] = (f32x4){0.f, 0.f, 0.f, 0.f};
        cur = nxt; cA = nA; cB = nB; ++ui;
        if constexpr (ALIGN_EPI) { if (wr == 1) PG8_BAR; }
    }
    PG8_WAIT_V(0);
    if constexpr (!ALIGN_EPI) { if (wr == 0) PG8_BAR; }
    PG8_BAR;
#undef PG8_UA
#undef PG8_UB
#undef PG8_SA
#undef PG8_SB
#undef PG8_STAGE
#undef PG8_LDA
#undef PG8_LDB
#undef PG8_MMA
#undef PG8_WAIT_V
#undef PG8_WAIT_L
#undef PG8_BAR
#undef PG8_SCHED
}
}

namespace att {
using bf16 = __hip_bfloat16;
using bf16x8 = __attribute__((ext_vector_type(8))) short;
using s16x4  = __attribute__((ext_vector_type(4))) short;
using f32x16 = __attribute__((ext_vector_type(16))) float;
using u32x4  = __attribute__((ext_vector_type(4))) unsigned;
constexpr int D = 128, NW = 8, QBLK = 32, KVBLK = 64;
constexpr float SCALE = 0.088388347648318440f;
constexpr float THR = 8.f;
constexpr int LDQ = 4096, LDK = 4096, LDO = 8192;
constexpr int SHM_V = KVBLK * D * 2, SHM_K = KVBLK * D * 2, SHM_ATTN = 2 * SHM_V + 2 * SHM_K + NW * 64 * 4;
#define KSWZ(row, colB) ((row) * 256 + ((colB) ^ (((row) & 7) << 4)))
#define SBAR() __builtin_amdgcn_sched_barrier(0)
__device__ __forceinline__ int crow(int r, int hi) { return (r & 3) + 8 * (r >> 2) + 4 * hi; }
__device__ __forceinline__ unsigned cvtpk(float lo, float hi) { unsigned r; asm volatile("v_cvt_pk_bf16_f32 %0, %1, %2" : "=v"(r) : "v"(lo), "v"(hi)); return r; }

__device__ __forceinline__ void partialSM(f32x16& p0, f32x16& p1, float& m_reg, float& mn, float& alpha) {
  constexpr float C = SCALE * 1.4426950408889634f;
  float pmax = p0[0]; for (int r = 1; r < 16; ++r) pmax = fmaxf(pmax, p0[r]); for (int r = 0; r < 16; ++r) pmax = fmaxf(pmax, p1[r]);
  { auto rr = __builtin_amdgcn_permlane32_swap(__float_as_uint(pmax), __float_as_uint(pmax), false, false);
    pmax = fmaxf(__uint_as_float(rr[0]), __uint_as_float(rr[1])); }
  if (__builtin_expect(__all(pmax - m_reg <= THR / SCALE), 1)) { mn = m_reg; alpha = 1.f; }
  else { mn = fmaxf(m_reg, pmax); alpha = __builtin_amdgcn_exp2f((m_reg - mn) * C); m_reg = mn; }
  float mnC = -mn * C;
  for (int r = 0; r < 16; ++r) p0[r] = fmaf(p0[r], C, mnC); for (int r = 0; r < 16; ++r) p1[r] = fmaf(p1[r], C, mnC);
  for (int r = 0; r < 16; ++r) p0[r] = __builtin_amdgcn_exp2f(p0[r]);
}
__device__ __forceinline__ void finishSM(f32x16& p0, f32x16& p1, float alpha, float& l_reg, bf16x8& pa0, bf16x8& pa1, bf16x8& pa2, bf16x8& pa3) {
  for (int r = 0; r < 16; ++r) p1[r] = __builtin_amdgcn_exp2f(p1[r]);
  float ps = 0; for (int r = 0; r < 16; ++r) ps += p0[r]; for (int r = 0; r < 16; ++r) ps += p1[r];
  { auto rr = __builtin_amdgcn_permlane32_swap(__float_as_uint(ps), __float_as_uint(ps), false, false);
    ps = __uint_as_float(rr[0]) + __uint_as_float(rr[1]); }
  l_reg = l_reg * alpha + ps;
#define PK4(P, BASE, OUT) do { unsigned a0 = cvtpk(P[BASE + 0], P[BASE + 1]), a1 = cvtpk(P[BASE + 2], P[BASE + 3]);   \
    unsigned b0 = cvtpk(P[BASE + 4], P[BASE + 5]), b1 = cvtpk(P[BASE + 6], P[BASE + 7]);                              \
    auto r0 = __builtin_amdgcn_permlane32_swap(a0, b0, false, false); auto r1 = __builtin_amdgcn_permlane32_swap(a1, b1, false, false); \
    u32x4 w = {r0[0], r1[0], r0[1], r1[1]}; OUT = *reinterpret_cast<bf16x8*>(&w); } while (0)
  PK4(p0, 0, pa0); PK4(p0, 8, pa1); PK4(p1, 0, pa2); PK4(p1, 8, pa3);
#undef PK4
}
__device__ __forceinline__ void qkt(f32x16& p0, f32x16& p1, const bf16* Ks, const bf16x8* qr, int r32, int hi, bool act) {
  if (!act) { const float NEG = -__builtin_inff();
#pragma unroll
    for (int r = 0; r < 16; ++r) { p0[r] = NEG; p1[r] = NEG; } return; }
  p0 = f32x16{}; p1 = f32x16{};
#pragma unroll
  for (int d0 = 0; d0 < 8; ++d0) { int cb = (d0 * 16 + hi * 8) * 2;
    bf16x8 b0 = *reinterpret_cast<const bf16x8*>((const char*)Ks + KSWZ(r32, cb));
    bf16x8 b1 = *reinterpret_cast<const bf16x8*>((const char*)Ks + KSWZ(32 + r32, cb));
    p0 = __builtin_amdgcn_mfma_f32_32x32x16_bf16(b0, qr[d0], p0, 0, 0, 0);
    p1 = __builtin_amdgcn_mfma_f32_32x32x16_bf16(b1, qr[d0], p1, 0, 0, 0); }
}
__device__ __forceinline__ int v_st(int k, int c) { const int kk = (k & ~0xC) | ((k & 4) << 1) | ((k & 8) >> 1); return ((kk >> 3) * 4 + (c >> 5)) * 512 + ((kk & 7) * 32 + (c & 31)) * 2; }
__device__ __forceinline__ int v_rd_base(int lane) { return ((lane & 3) << 3) | (((lane >> 2) & 3) << 6) | (((lane >> 4) & 1) << 5) | (((lane >> 5) & 1) << 8); }
constexpr int v_rd_off(int d0, int ks, int half) { return d0 * 512 + ks * 4096 + half * 2048; }
template <int OFF> __device__ __forceinline__ s16x4 tr_read(int vb) {
  s16x4 r; asm volatile("ds_read_b64_tr_b16 %0, %1 offset:%2" : "=&v"(r) : "v"(vb), "i"(OFF) : "memory"); return r;
}
template <int D0> __device__ __forceinline__ void pv_one(f32x16& od, int vb, bf16x8 pa0, bf16x8 pa1, bf16x8 pa2, bf16x8 pa3) {
  const s16x4 l0 = tr_read<v_rd_off(D0, 0, 0)>(vb), h0 = tr_read<v_rd_off(D0, 0, 1)>(vb), l1 = tr_read<v_rd_off(D0, 1, 0)>(vb), h1 = tr_read<v_rd_off(D0, 1, 1)>(vb);
  const s16x4 l2 = tr_read<v_rd_off(D0, 2, 0)>(vb), h2 = tr_read<v_rd_off(D0, 2, 1)>(vb), l3 = tr_read<v_rd_off(D0, 3, 0)>(vb), h3 = tr_read<v_rd_off(D0, 3, 1)>(vb);
  asm volatile("s_waitcnt lgkmcnt(0)" ::: "memory"); SBAR();
#define PK(L, H) (bf16x8){L[0], L[1], L[2], L[3], H[0], H[1], H[2], H[3]}
  od = __builtin_amdgcn_mfma_f32_32x32x16_bf16(pa0, PK(l0, h0), od, 0, 0, 0);
  od = __builtin_amdgcn_mfma_f32_32x32x16_bf16(pa1, PK(l1, h1), od, 0, 0, 0);
  od = __builtin_amdgcn_mfma_f32_32x32x16_bf16(pa2, PK(l2, h2), od, 0, 0, 0);
  od = __builtin_amdgcn_mfma_f32_32x32x16_bf16(pa3, PK(l3, h3), od, 0, 0, 0);
#undef PK
}
__device__ __forceinline__ void pv_d0(f32x16* o, int vb, bf16x8 pa0, bf16x8 pa1, bf16x8 pa2, bf16x8 pa3, bool act) {
  if (!act) return;
  pv_one<0>(o[0], vb, pa0, pa1, pa2, pa3); pv_one<1>(o[1], vb, pa0, pa1, pa2, pa3); pv_one<2>(o[2], vb, pa0, pa1, pa2, pa3); pv_one<3>(o[3], vb, pa0, pa1, pa2, pa3);
}

__device__ __forceinline__ void attn_unit(const bf16* __restrict__ Qb, const bf16* __restrict__ Kh, const bf16* __restrict__ Vh, bf16* __restrict__ Ob, int NT, int jw, char* lds) {
  const int tid = threadIdx.x, wid = tid >> 6, lane = tid & 63, r32 = lane & 31, hi = lane >> 5;
  bf16* V_lds = (bf16*)lds; bf16* K_lds = (bf16*)(lds + 2 * SHM_V);
  float* ws = (float*)(lds + 2 * SHM_V + 2 * SHM_K) + wid * 64; float* li_l = ws; float* al_l = ws + 32;
  float m_reg = -1e30f, l_reg = 0; f32x16 o[4] = {}; bf16x8 qr[8];
  { const __amdgpu_buffer_rsrc_t qrs = __builtin_amdgcn_make_buffer_rsrc((void*)Qb, 0, 0x7fffffff, 0x00020000);
    const int qoff = ((wid * QBLK + r32) * LDQ + hi * 8) * 2;
#pragma unroll
    for (int d0 = 0; d0 < 8; ++d0) qr[d0] = __builtin_bit_cast(bf16x8, __builtin_amdgcn_raw_buffer_load_b128(qrs, qoff + d0 * 32, 0, 0)); }
  const int sr = tid >> 4, sc = (tid & 15) * 8, vst0 = v_st(sr, sc), vst1 = v_st(32 + sr, sc);
  const int vb0 = (int)(uintptr_t)V_lds + v_rd_base(lane);
  struct { bf16x8 vs0, vs1, ks0, ks1; } sr_[2];
  const int toff0 = (sr * LDK + sc) * 2, toff1 = toff0 + 32 * LDK * 2;
  const __amdgpu_buffer_rsrc_t krs = __builtin_amdgcn_make_buffer_rsrc((void*)Kh, 0, 0x7fffffff, 0x00020000), vrs = __builtin_amdgcn_make_buffer_rsrc((void*)Vh, 0, 0x7fffffff, 0x00020000);
#define BLD(rs, vo, so) __builtin_bit_cast(bf16x8, __builtin_amdgcn_raw_buffer_load_b128(rs, vo, so, 0))
#define SLOAD(i, k0) do { const int so_ = (k0) * (LDK * 2); \
    sr_[i].vs0 = BLD(vrs, toff0, so_); sr_[i].vs1 = BLD(vrs, toff1, so_); sr_[i].ks0 = BLD(krs, toff0, so_); sr_[i].ks1 = BLD(krs, toff1, so_); } while (0)
#define SWRITE(b, i) do { *(bf16x8*)((char*)V_lds + (b) * SHM_V + vst0) = sr_[i].vs0;          \
    *(bf16x8*)((char*)V_lds + (b) * SHM_V + vst1) = sr_[i].vs1; int kc = sc * 2;               \
    *(bf16x8*)((char*)K_lds + (b) * SHM_K + KSWZ(sr, kc)) = sr_[i].ks0;                       \
    *(bf16x8*)((char*)K_lds + (b) * SHM_K + KSWZ(32 + sr, kc)) = sr_[i].ks1; } while (0)
#define SWAIT() asm volatile("s_waitcnt vmcnt(4)" ::: "memory")
#define RESC(a) do { if (__any((a) < 1.f)) { if (hi == 0) al_l[r32] = (a); asm volatile("s_waitcnt lgkmcnt(0)" ::: "memory"); \
    for (int d = 0; d < 4; ++d) for (int r = 0; r < 16; ++r) o[d][r] *= al_l[crow(r, hi)]; } } while (0)
#define ACT(t) ((t) <= jw)
  f32x16 pA0, pA1, pB0, pB1; float mnA, mnB, alA, alB; bf16x8 pa0, pa1, pa2, pa3;
  constexpr int SE = 0, SO = 1;
  SLOAD(SE, 0); asm volatile("s_waitcnt vmcnt(0)" ::: "memory"); SWRITE(0, SE); __syncthreads();
  qkt(pA0, pA1, K_lds, qr, r32, hi, true); partialSM(pA0, pA1, m_reg, mnA, alA);
  SLOAD(SO, KVBLK); if (2 < NT) SLOAD(SE, 2 * KVBLK);
  SWAIT(); SWRITE(1, SO); __syncthreads();
  for (int j = 1; j + 1 < NT; j += 2) {
    SBAR(); qkt(pB0, pB1, (bf16*)((char*)K_lds + SHM_K), qr, r32, hi, ACT(j));
    finishSM(pA0, pA1, alA, l_reg, pa0, pa1, pa2, pa3); SBAR();
    SLOAD(SO, (j + 2) * KVBLK); SBAR();
    pv_d0(o, vb0, pa0, pa1, pa2, pa3, ACT(j - 1)); partialSM(pB0, pB1, m_reg, mnB, alB);
    __syncthreads(); SWAIT(); SWRITE(0, SE);
    RESC(alB); __syncthreads();
    SBAR(); qkt(pA0, pA1, K_lds, qr, r32, hi, ACT(j + 1));
    finishSM(pB0, pB1, alB, l_reg, pa0, pa1, pa2, pa3); SBAR();
    if (j + 3 < NT) SLOAD(SE, (j + 3) * KVBLK); SBAR();
    pv_d0(o, vb0 + (int)SHM_V, pa0, pa1, pa2, pa3, ACT(j)); partialSM(pA0, pA1, m_reg, mnA, alA);
    __syncthreads(); SWAIT(); SWRITE(1, SO);
    RESC(alA); __syncthreads();
  }
  SBAR(); qkt(pB0, pB1, (bf16*)((char*)K_lds + SHM_K), qr, r32, hi, ACT(NT - 1));
  finishSM(pA0, pA1, alA, l_reg, pa0, pa1, pa2, pa3); SBAR();
  pv_d0(o, vb0, pa0, pa1, pa2, pa3, ACT(NT - 2)); partialSM(pB0, pB1, m_reg, mnB, alB);
  __syncthreads(); RESC(alB);
  finishSM(pB0, pB1, alB, l_reg, pa0, pa1, pa2, pa3); SBAR();
  pv_d0(o, vb0 + (int)SHM_V, pa0, pa1, pa2, pa3, ACT(NT - 1));
  if (hi == 0) li_l[r32] = l_reg; asm volatile("s_waitcnt lgkmcnt(0)" ::: "memory");
  float rli[16];
#pragma unroll
  for (int r = 0; r < 16; ++r) rli[r] = __builtin_amdgcn_rcpf(li_l[crow(r, hi)]);
  { const __amdgpu_buffer_rsrc_t ors = __builtin_amdgcn_make_buffer_rsrc((void*)Ob, 0, 0x7fffffff, 0x00020000);
    const int ooff = ((wid * QBLK + 4 * hi) * LDO + r32) * 2;
#pragma unroll
    for (int r = 0; r < 16; ++r) { const int orow = (r & 3) + 8 * (r >> 2);
#pragma unroll
      for (int d0 = 0; d0 < 4; ++d0) { const float v = o[d0][r] * rli[r]; const float vn = __shfl_xor(v, 1);
        if ((r32 & 1) == 0) __builtin_amdgcn_raw_buffer_store_b32(cvtpk(v, vn), ors, ooff + (orow * LDO + d0 * 32) * 2, 0, 0); } } }
  __syncthreads();
#undef SLOAD
#undef BLD
#undef SWRITE
#undef SWAIT
#undef RESC
#undef ACT
}
#undef KSWZ
#undef SBAR
}

constexpr int NWAVES = 8;
constexpr int S_ = 8192, DM = 4096, PW = 8192, PG = 2048, AW = 4096, NH = 16, DH = 128;
constexpr float EPS = 1e-6f;
constexpr float LAM_INIT = 0.35550906759096934f;

constexpr size_t MiB = 1u << 20;
constexpr size_t WS_CTL = 0, CTL_ZERO_BYTES = 1 * MiB;
constexpr size_t WS_ADA = 1 * MiB;
constexpr size_t WS_COS = 2 * MiB, WS_SIN = 4 * MiB;
constexpr size_t WS_W_IN = 8 * MiB;
constexpr size_t WS_W_GRP = 136 * MiB;
constexpr size_t WS_W_OUTA = 168 * MiB;
constexpr size_t WS_W_KVQG = 232 * MiB;
constexpr size_t WS_W_OUTB = 360 * MiB;
constexpr size_t WS_H1 = 392 * MiB;
constexpr size_t WS_HN = 520 * MiB;
constexpr size_t WS_UZ = 584 * MiB;
constexpr size_t WS_POOL = 840 * MiB;
constexpr size_t WS_Y = 968 * MiB;
constexpr size_t WS_KVN = 520 * MiB;
constexpr size_t WS_HNB = 584 * MiB;
constexpr size_t WS_K = 648 * MiB, WS_V = 712 * MiB, WS_Q = 776 * MiB, WS_Z = 840 * MiB;
constexpr size_t WS_OC = 904 * MiB;
constexpr size_t WS_YB = 1032 * MiB;
constexpr size_t WS_END = 1096 * MiB;
constexpr int CW_BAR = 4096;

constexpr int RING_OFF = 0;
constexpr int LDSCTL_OFF = 143360, MISC_OFF = LDSCTL_OFF + 320;
constexpr int LDS_BYTES = 147456;

#define GAS __attribute__((address_space(1)))
#define LAS __attribute__((address_space(3)))
typedef unsigned short bf16;
typedef unsigned v4u __attribute__((ext_vector_type(4)));
typedef unsigned v2u __attribute__((ext_vector_type(2)));
typedef float f32x4 __attribute__((ext_vector_type(4)));
typedef GAS unsigned gu32;
#define RLX_AGENT __ATOMIC_RELAXED, __HIP_MEMORY_SCOPE_AGENT
#define LDS_WAIT() asm volatile("s_waitcnt lgkmcnt(0)" ::: "memory")
#define VM_WAIT() asm volatile("s_waitcnt vmcnt(0)" ::: "memory")
__device__ __forceinline__ unsigned pk2(float lo, float hi) { return pg8::cvt_pk_bf16(lo, hi); }

#define XB_TMO      128
#define XB_XCNT(j)  (256  + 64 * (j))
#define XB_XSUB(j)  (1280 + 64 * (j))
#define XB_XGEN(j)  (2304 + 64 * (j))
#define XB_TOP      3328
#define XB_TOPGEN   3392
#define XCD_BAR_WORDS 3456
#define XB_SPIN_CAP (1u << 18)

__device__ __forceinline__ unsigned xb_ld(unsigned* p)              { return __hip_atomic_load(p, __ATOMIC_RELAXED, __HIP_MEMORY_SCOPE_AGENT); }
__device__ __forceinline__ unsigned xb_add(unsigned* p, unsigned v) { return __hip_atomic_fetch_add(p, v, __ATOMIC_RELAXED, __HIP_MEMORY_SCOPE_AGENT); }
__device__ __forceinline__ unsigned xb_xcc_id() { return (unsigned)__builtin_amdgcn_s_getreg((3 << 11) | 20) & 0xFu; }
#define XB_SPIN(cond, bar) do { unsigned _sp = 0; while (cond) { __builtin_amdgcn_s_sleep(1); \
    if ((++_sp & 255u) == 0u) { if (xb_ld(&(bar)[XB_TMO])) break; if (_sp > XB_SPIN_CAP) { atomicAdd(&(bar)[XB_TMO], 1u); break; } } } } while (0)

struct XcdBarrier { unsigned* bar; unsigned x; volatile LAS unsigned* st; };

__device__ __forceinline__ XcdBarrier xcd_barrier_post(unsigned* bar, volatile LAS unsigned* st) {
    XcdBarrier b; b.bar = bar; b.x = xb_xcc_id(); b.st = st;
    if (threadIdx.x == 0) (void)xb_add(&bar[XB_XCNT(b.x)], 1u);
    return b;
}
__device__ __forceinline__ void xcd_barrier_complete(unsigned* bar, unsigned x, unsigned& nloc, unsigned& nx) {
    const unsigned G = gridDim.x * gridDim.y * gridDim.z;
    unsigned sum, cnt, mine, sp = 0u;
    for (;;) {
        sum = 0u; cnt = 0u; mine = 0u;
#pragma unroll
        for (unsigned j = 0; j < 16; ++j) { const unsigned c = xb_ld(&bar[XB_XCNT(j)]); sum += c; cnt += (c > 0u) ? 1u : 0u; mine = (j == x) ? c : mine; }
        if (sum == G) break;
        __builtin_amdgcn_s_sleep(1);
        if ((++sp & 255u) == 0u) { if (xb_ld(&bar[XB_TMO])) break; if (sp > XB_SPIN_CAP) { atomicAdd(&bar[XB_TMO], 1u); break; } }
    }
    nloc = mine > 0u ? mine : 1u; nx = cnt > 0u ? cnt : 1u;
}
__device__ __forceinline__ void xcd_barrier(const XcdBarrier& b) {
    asm volatile("s_waitcnt vmcnt(0)" ::: "memory");
    __syncthreads();
    if (threadIdx.x == 0) {
        unsigned* bar = b.bar;
        __builtin_amdgcn_s_waitcnt(0);
        unsigned nloc = b.st[0], nx = b.st[1];
        if (nloc == 0u) { xcd_barrier_complete(bar, b.x, nloc, nx); b.st[0] = nloc; b.st[1] = nx; }
        const unsigned old = xb_add(&bar[XB_XSUB(b.x)], 1u);
        const unsigned gen = old / nloc;
        if (old + 1u == (gen + 1u) * nloc) {
            __builtin_amdgcn_fence(__ATOMIC_RELEASE, "agent");
            asm volatile("s_waitcnt vmcnt(0)" ::: "memory");
            const unsigned og = xb_add(&bar[XB_TOP], 1u);
            const unsigned tg = og / nx;
            if (og + 1u == (tg + 1u) * nx) xb_add(&bar[XB_TOPGEN], 1u);
            else XB_SPIN(xb_ld(&bar[XB_TOPGEN]) == tg, bar);
            __builtin_amdgcn_fence(__ATOMIC_ACQUIRE, "agent");
            xb_add(&bar[XB_XGEN(b.x)], 1u);
            asm volatile("s_waitcnt vmcnt(0)" ::: "memory");
        } else {
            XB_SPIN(xb_ld(&bar[XB_XGEN(b.x)]) == gen, bar);
            __builtin_amdgcn_fence(__ATOMIC_ACQUIRE, "agent");
            asm volatile("s_waitcnt vmcnt(0)" ::: "memory");
        }
    }
    __syncthreads();
}

struct Frame {
    LAS unsigned char* lds;
    volatile LAS unsigned* MISC;
    gu32* ctl;
    int tid, lane, wave;
    int vcu, G;
};
struct Args {
    const float* x; const float* c; const int* pos;
    const float* a_norm_g; const float* a_ada_w; const float* a_ada_b; const float* a_w_in; const float* a_w_group; const float* a_scale; const float* a_w_out;
    const float* kv_norm_g; const float* kv_ada_w; const float* kv_ada_b; const float* w_kv;
    const float* b_norm_g; const float* b_ada_w; const float* b_ada_b; const float* b_w_qg; const float* b_lam; const float* b_subln_g; const float* b_w_out; const float* final_g;
    float* out; unsigned char* ws; int ph_lo, ph_hi, li, pad;
};

__device__ __forceinline__ float wave_sum(float v) {
#pragma unroll
    for (int o = 1; o < 64; o <<= 1) v += __shfl_xor(v, o);
    return v;
}
__device__ __forceinline__ float half_sum(float v) {
#pragma unroll
    for (int o = 1; o < 32; o <<= 1) v += __shfl_xor(v, o);
    return v;
}

__device__ __forceinline__ void p0_ada(Frame& F, const Args& a) {
    LAS float* sc = (LAS float*)(F.lds + RING_OFF);
    LAS float* part = sc + 4096;
    for (int k = F.tid; k < DM; k += NWAVES * 64) { const float c = a.c[k]; sc[k] = pg8::silu_f(c); }
    __syncthreads();
    float* mall = (float*)(a.ws + WS_ADA);
    const int cg = F.lane & 31, kp = F.lane >> 5;
    for (int slab = blockIdx.x; slab < 256; slab += F.G) {
        const int j0 = slab * 128;
        const float* W; const float* bias; int N, c0;
        if (j0 < 12288) { W = a.a_ada_w; bias = a.a_ada_b; N = 12288; c0 = j0; }
        else if (j0 < 20480) { W = a.kv_ada_w; bias = a.kv_ada_b; N = 8192; c0 = j0 - 12288; }
        else { W = a.b_ada_w; bias = a.b_ada_b; N = 12288; c0 = j0 - 20480; }
        const float* wp = W + (size_t)(512 * F.wave + kp) * N + c0 + 4 * cg;
        const LAS float* sp = sc + 512 * F.wave + kp;
        f32x4 acc = (f32x4){0.f, 0.f, 0.f, 0.f};
#pragma unroll 16
        for (int i = 0; i < 256; ++i) { const f32x4 wv = *(const GAS f32x4*)(wp + (size_t)(2 * i) * N); acc += sp[2 * i] * wv; }
#pragma unroll
        for (int e = 0; e < 4; ++e) acc[e] += __shfl_xor(acc[e], 32);
        if (kp == 0) { LAS float* pp = part + F.wave * 128 + 4 * cg; pp[0] = acc[0]; pp[1] = acc[1]; pp[2] = acc[2]; pp[3] = acc[3]; }
        __syncthreads();
        if (F.tid < 128) { float s = bias[c0 + F.tid];
#pragma unroll
            for (int w = 0; w < 8; ++w) s += part[w * 128 + F.tid];
            mall[j0 + F.tid] = s; }
        __syncthreads();
    }
}
__device__ __forceinline__ void p0_rope(Frame& F, const Args& a) {
    float* cs = (float*)(a.ws + WS_COS); float* sn = (float*)(a.ws + WS_SIN);
    const int gt = blockIdx.x * (NWAVES * 64) + F.tid, NT = F.G * NWAVES * 64;
    for (int idx = gt; idx < S_ * 64; idx += NT) {
        const int row = idx >> 6, i = idx & 63;
        double inv = 1.0, b = 0.8659643233600653; int e = i;
        while (e) { if (e & 1) inv *= b; b *= b; e >>= 1; }
        const double ang = (double)a.pos[row] * inv;
        const double kq = rint(ang * 0.63661977236758134308);
        double r = fma(-kq, 1.5707963267948966, ang); r = fma(-kq, 6.123233995736766e-17, r);
        const double r2 = r * r;
        double sp = -7.6471637318198164759e-13; sp = fma(sp, r2, 1.6059043836821614599e-10); sp = fma(sp, r2, -2.5052108385441718775e-8); sp = fma(sp, r2, 2.7557319223985890653e-6);
        sp = fma(sp, r2, -1.9841269841269841270e-4); sp = fma(sp, r2, 8.3333333333333333333e-3); sp = fma(sp, r2, -1.6666666666666666667e-1); sp = fma(sp * r2, r, r);
        double cp = 4.7794773323873852974e-14; cp = fma(cp, r2, -1.1470745597729724714e-11); cp = fma(cp, r2, 2.0876756987868098979e-9); cp = fma(cp, r2, -2.7557319223985890653e-7);
        cp = fma(cp, r2, 2.4801587301587301587e-5); cp = fma(cp, r2, -1.3888888888888888889e-3); cp = fma(cp, r2, 4.1666666666666666667e-2); cp = fma(cp, r2, -0.5); cp = fma(cp, r2, 1.0);
        const int q = ((int)kq) & 3;
        const double sv = (q == 0) ? sp : (q == 1) ? cp : (q == 2) ? -sp : -cp;
        const double cv = (q == 0) ? cp : (q == 1) ? -sp : (q == 2) ? -cp : sp;
        cs[idx] = (float)cv; sn[idx] = (float)sv;
    }
}
template <bool ROPE>
__device__ __forceinline__ void p0_transpose_item(const float* W, int K, int N, bf16* WT, int row_off, LAS float* scr, int item, int lane) {
    const int nblk = N / 64, kb = item / nblk, nb = item % nblk, k0 = 64 * kb, n0 = 64 * nb;
    f32x4 v[16];
    const float* wp = W + (size_t)(k0 + (lane >> 4)) * N + n0 + 4 * (lane & 15);
#pragma unroll
    for (int i = 0; i < 16; ++i) v[i] = *(const GAS f32x4*)(wp + (size_t)(4 * i) * N);
#pragma unroll
    for (int i = 0; i < 16; ++i) { LAS float* s = scr + (4 * i + (lane >> 4)) * 65 + 4 * (lane & 15); s[0] = v[i][0]; s[1] = v[i][1]; s[2] = v[i][2]; s[3] = v[i][3]; }
    LDS_WAIT(); asm volatile("" ::: "memory");
    const int c = lane & 7;
#pragma unroll
    for (int j = 0; j < 8; ++j) { const int n = (lane >> 3) + 8 * j; const LAS float* s = scr + (8 * c) * 65 + n;
        v4u o; o.x = pk2(s[0 * 65], s[1 * 65]); o.y = pk2(s[2 * 65], s[3 * 65]); o.z = pk2(s[4 * 65], s[5 * 65]); o.w = pk2(s[6 * 65], s[7 * 65]);
        int ng = n0 + n;
        if (ROPE && ng < 4096) { const int p = ng & 127; ng = (ng & ~127) + ((p < 64) ? 2 * p : 2 * (p - 64) + 1); }
        *(GAS v4u*)(WT + (size_t)(row_off + ng) * K + k0 + 8 * c) = o; }
    LDS_WAIT(); asm volatile("" ::: "memory");
}
__device__ __forceinline__ void p0_convert(Frame& F, const Args& a) {
    LAS float* scr = (LAS float*)(F.lds + RING_OFF) + F.wave * (64 * 65);
    const int gw = F.vcu * NWAVES + F.wave, NGW = F.G * NWAVES;
    constexpr int I_IN = (DM / 64) * (2 * PW / 64), I_GRP = (PG / 64) * (PG / 64), I_OA = (PW / 64) * (DM / 64), I_KV = (DM / 64) * (2 * AW / 64), I_OB = (AW / 64) * (DM / 64);
    constexpr int NITEMS = I_IN + 4 * I_GRP + I_OA + 2 * I_KV + I_OB;
    unsigned char* ws = a.ws;
    for (int it = gw; it < NITEMS; it += NGW) {
        int r = it;
        if (r < I_IN) { p0_transpose_item<false>(a.a_w_in, DM, 2 * PW, (bf16*)(ws + WS_W_IN), 0, scr, r, F.lane); continue; } r -= I_IN;
        if (r < 4 * I_GRP) { const int g = r / I_GRP; p0_transpose_item<false>(a.a_w_group + (size_t)g * PG * PG, PG, PG, (bf16*)(ws + WS_W_GRP), g * PG, scr, r % I_GRP, F.lane); continue; } r -= 4 * I_GRP;
        if (r < I_OA) { p0_transpose_item<false>(a.a_w_out, PW, DM, (bf16*)(ws + WS_W_OUTA), 0, scr, r, F.lane); continue; } r -= I_OA;
        if (r < I_KV) { p0_transpose_item<true>(a.w_kv, DM, 2 * AW, (bf16*)(ws + WS_W_KVQG), 0, scr, r, F.lane); continue; } r -= I_KV;
        if (r < I_KV) { p0_transpose_item<true>(a.b_w_qg, DM, 2 * AW, (bf16*)(ws + WS_W_KVQG), 2 * AW, scr, r, F.lane); continue; } r -= I_KV;
        p0_transpose_item<false>(a.b_w_out, AW, DM, (bf16*)(ws + WS_W_OUTB), 0, scr, r, F.lane);
    }
}
template <int NOUT>
__device__ __forceinline__ void norm_mod_rows(Frame& F, const float* xin, bf16* out0, bf16* out1, const LAS float* tab) {
    const int gw = F.vcu * NWAVES + F.wave, NGW = F.G * NWAVES;
    for (int m = gw; m < S_; m += NGW) {
        const GAS f32x4* xr = (const GAS f32x4*)(xin + (size_t)m * DM) + F.lane;
        f32x4 v[16]; float s = 0.f;
#pragma unroll
        for (int j = 0; j < 16; ++j) { v[j] = xr[64 * j]; s += (v[j].x * v[j].x + v[j].y * v[j].y) + (v[j].z * v[j].z + v[j].w * v[j].w); }
        const float rstd = 1.0f / sqrtf(wave_sum(s) * (1.f / DM) + EPS);
#pragma unroll
        for (int o = 0; o < NOUT; ++o) {
            GAS v2u* op = (GAS v2u*)((o == 0 ? out0 : out1) + (size_t)m * DM) + F.lane;
            const LAS f32x4* gs = (const LAS f32x4*)(tab + o * 2 * DM) + F.lane; const LAS f32x4* sh = (const LAS f32x4*)(tab + o * 2 * DM + DM) + F.lane;
#pragma unroll
            for (int j = 0; j < 16; ++j) { const f32x4 g = gs[64 * j], h = sh[64 * j]; const f32x4 y = v[j] * rstd * g + h;
                v2u w; w.x = pk2(y.x, y.y); w.y = pk2(y.z, y.w); op[64 * j] = w; }
        }
    }
}
__device__ __forceinline__ void unpack8(const v4u u, float* f) {
    f[0] = pg8::bf_lo(u.x); f[1] = pg8::bf_hi(u.x); f[2] = pg8::bf_lo(u.y); f[3] = pg8::bf_hi(u.y); f[4] = pg8::bf_lo(u.z); f[5] = pg8::bf_hi(u.z); f[6] = pg8::bf_lo(u.w); f[7] = pg8::bf_hi(u.w);
}
__device__ __forceinline__ void p3_pool(Frame& F, const Args& a) {
    const bf16* U = (const bf16*)(a.ws + WS_UZ); bf16* P = (bf16*)(a.ws + WS_POOL);
    const int gt = F.vcu * (NWAVES * 64) + F.tid, NT = F.G * NWAVES * 64;
    constexpr int RB = 32, NCH = PW / 8, NITEM = (S_ / RB) * NCH;
    for (int it = gt; it < NITEM; it += NT) {
        const int ch = it % NCH, rb = it / NCH, t0 = rb * RB, w = 2 << (ch >> 8);
        const bf16* up = U + (size_t)ch * 8; bf16* pp = P + (size_t)ch * 8;
        float sum[8]; float f[8];
#pragma unroll
        for (int e = 0; e < 8; ++e) sum[e] = 0.f;
        for (int j = 1; j < w; ++j) { const int t = t0 - j; if (t >= 0) { unpack8(*(const GAS v4u*)(up + (size_t)t * (2 * PW)), f);
#pragma unroll
            for (int e = 0; e < 8; ++e) sum[e] += f[e]; } }
#pragma unroll 4
        for (int t = t0; t < t0 + RB; ++t) {
            unpack8(*(const GAS v4u*)(up + (size_t)t * (2 * PW)), f);
            const float rc = 1.0f / (float)((t + 1 < w) ? (t + 1) : w);
            float o[8];
#pragma unroll
            for (int e = 0; e < 8; ++e) { sum[e] += f[e]; o[e] = sum[e] * rc - f[e]; }
            v4u ov; ov.x = pk2(o[0], o[1]); ov.y = pk2(o[2], o[3]); ov.z = pk2(o[4], o[5]); ov.w = pk2(o[6], o[7]);
            *(GAS v4u*)(pp + (size_t)t * PW) = ov;
            const int tl = t - w + 1;
            if (tl >= 0) { unpack8(*(const GAS v4u*)(up + (size_t)tl * (2 * PW)), f);
#pragma unroll
                for (int e = 0; e < 8; ++e) sum[e] -= f[e]; }
        }
    }
}
__device__ __forceinline__ void p9_combine(Frame& F, const Args& a) {
    float d1 = 0.f, d2 = 0.f;
    for (int i = F.lane; i < DH; i += 64) { d1 += a.b_lam[i] * a.b_lam[DH + i]; d2 += a.b_lam[2 * DH + i] * a.b_lam[3 * DH + i]; }
    d1 = wave_sum(d1); d2 = wave_sum(d2);
    const float lam = expf(d1) - expf(d2) + LAM_INIT;
    const bf16* OC = (const bf16*)(a.ws + WS_OC); const bf16* Z = (const bf16*)(a.ws + WS_Z); bf16* YB = (bf16*)(a.ws + WS_YB);
    const int gw = F.vcu * NWAVES + F.wave, NGW = F.G * NWAVES;
    float g8[8];
    { const float* gp = a.b_subln_g + 8 * (F.lane & 31);
#pragma unroll
      for (int e = 0; e < 8; ++e) g8[e] = gp[e] * (1.0f - LAM_INIT); }
    for (int m = gw; m < S_; m += NGW) {
        const GAS v4u* o0p = (const GAS v4u*)(OC + (size_t)m * (2 * AW)) + F.lane; const GAS v4u* o1p = (const GAS v4u*)(OC + (size_t)m * (2 * AW) + AW) + F.lane;
        const GAS v4u* zp = (const GAS v4u*)(Z + (size_t)m * AW) + F.lane; GAS v4u* yp = (GAS v4u*)(YB + (size_t)m * AW) + F.lane;
#pragma unroll 2
        for (int j = 0; j < 8; ++j) {
            float f0[8], f1[8], fz[8], o[8];
            unpack8(o0p[64 * j], f0); unpack8(o1p[64 * j], f1); unpack8(zp[64 * j], fz);
            float ss = 0.f;
#pragma unroll
            for (int e = 0; e < 8; ++e) { o[e] = f0[e] - lam * f1[e]; ss += o[e] * o[e]; }
            const float rstd = 1.0f / sqrtf(half_sum(ss) * (1.f / 256.f) + EPS);
#pragma unroll
            for (int e = 0; e < 8; ++e) o[e] = o[e] * rstd * g8[e] * pg8::silu_f(fz[e]);
            v4u ov; ov.x = pk2(o[0], o[1]); ov.y = pk2(o[2], o[3]); ov.z = pk2(o[4], o[5]); ov.w = pk2(o[6], o[7]);
            yp[64 * j] = ov;
        }
    }
}
__device__ __forceinline__ void p11_final(Frame& F, const Args& a) {
    const int gw = F.vcu * NWAVES + F.wave, NGW = F.G * NWAVES;
    for (int m = gw; m < S_; m += NGW) {
        GAS f32x4* xr = (GAS f32x4*)(a.out + (size_t)m * DM) + F.lane; const GAS f32x4* gp = (const GAS f32x4*)a.final_g + F.lane;
        f32x4 v[16]; float s = 0.f;
#pragma unroll
        for (int j = 0; j < 16; ++j) { v[j] = xr[64 * j]; s += (v[j].x * v[j].x + v[j].y * v[j].y) + (v[j].z * v[j].z + v[j].w * v[j].w); }
        const float rstd = 1.0f / sqrtf(wave_sum(s) * (1.f / DM) + EPS);
#pragma unroll
        for (int j = 0; j < 16; ++j) xr[64 * j] = v[j] * rstd * gp[64 * j];
    }
}

__global__ void __launch_bounds__(NWAVES * 64, 2) yoco_fwd(Args args) {
    extern __shared__ __attribute__((aligned(16))) unsigned char lds[];
    Frame F;
    F.lds = (LAS unsigned char*)lds;
    F.MISC = (volatile LAS unsigned*)(F.lds + MISC_OFF);
    F.tid = threadIdx.x; F.lane = F.tid & 63; F.wave = __builtin_amdgcn_readfirstlane(F.tid >> 6);
    F.G = gridDim.x; { const int bx = blockIdx.x; F.vcu = (F.G % 8 == 0) ? (bx % 8) * (F.G / 8) + bx / 8 : bx; }
    unsigned char* ws = args.ws;
    F.ctl = (gu32*)(ws + WS_CTL);
    for (int u = F.tid; u < (LDS_BYTES - LDSCTL_OFF) / 4; u += NWAVES * 64) ((LAS unsigned*)(F.lds + LDSCTL_OFF))[u] = 0u;
    __syncthreads();
    XcdBarrier bar; bar.bar = (unsigned*)(F.ctl + CW_BAR); bar.x = 0; bar.st = nullptr;
    if (N_LAUNCHES == 1) bar = xcd_barrier_post((unsigned*)(F.ctl + CW_BAR), F.MISC + 8);
#define GRID_BAR() do { if (N_LAUNCHES == 1) xcd_barrier(bar); } while (0)
    const int lo = args.ph_lo, hi = args.ph_hi;
#define IN(k) (lo <= (k) && (k) < hi)
#define BOTH(k) (IN(k) && IN((k) + 1))
    const float* mall = (const float*)(ws + WS_ADA);

    if (IN(0)) { p0_ada(F, args); p0_rope(F, args); p0_convert(F, args); if (BOTH(0)) GRID_BAR(); }

    if (IN(1)) {
        LAS float* tab = (LAS float*)(F.lds + RING_OFF);
        for (int c = F.tid; c < DM; c += NWAVES * 64) { tab[c] = args.a_norm_g[c] * (1.0f + mall[DM + c]); tab[DM + c] = mall[c]; }
        __syncthreads();
        norm_mod_rows<1>(F, args.x, (bf16*)(ws + WS_HN), nullptr, tab);
        if (BOTH(1)) GRID_BAR();
    }
    if (IN(2)) {
        pg8::Gemm g{(const pg8::bf16_t*)(ws + WS_HN), (const pg8::bf16_t*)(ws + WS_W_IN), S_, 2 * PW, DM, DM, DM, 1 << 20, 0};
        pg8::StaticOrder S; S.init(S_, 2 * PW, F.G, (int)blockIdx.x);
        pg8::EpiBf16 E{(pg8::bf16_t*)(ws + WS_UZ), 2 * PW};
        pg8::gemm_phase<pg8::EpiBf16, pg8::StaticOrder, true, true>(F.lds + RING_OFF, g, S, E);
        if (BOTH(2)) GRID_BAR();
    }
    if (IN(3)) { p3_pool(F, args); if (BOTH(3)) GRID_BAR(); }
    if (IN(4)) {
        pg8::Gemm g{(const pg8::bf16_t*)(ws + WS_POOL), (const pg8::bf16_t*)(ws + WS_W_GRP), S_, PW, PG, PW, PG, 8, (long)PG * 2};
        pg8::StaticOrder S; S.init(S_, PW, F.G, (int)blockIdx.x);
        pg8::EpiPoolY E{(pg8::bf16_t*)(ws + WS_Y), PW, args.a_scale, (const pg8::bf16_t*)(ws + WS_UZ) + PW, 2 * PW};
        pg8::gemm_phase<pg8::EpiPoolY, pg8::StaticOrder, true, true>(F.lds + RING_OFF, g, S, E);
        if (BOTH(4)) GRID_BAR();
    }
    if (IN(5)) {
        pg8::Gemm g{(const pg8::bf16_t*)(ws + WS_Y), (const pg8::bf16_t*)(ws + WS_W_OUTA), S_, DM, PW, PW, PW, 1 << 20, 0};
        pg8::StaticOrder S; S.init(S_, DM, F.G, (int)blockIdx.x);
        pg8::EpiResid E{args.x, (float*)(ws + WS_H1), DM, mall + 2 * DM};
        pg8::gemm_phase<pg8::EpiResid, pg8::StaticOrder, true, true>(F.lds + RING_OFF, g, S, E);
        if (BOTH(5)) GRID_BAR();
    }
    if (IN(6)) {
        LAS float* tab = (LAS float*)(F.lds + RING_OFF);
        const float* mkv = mall + 12288; const float* mb = mall + 20480;
        for (int c = F.tid; c < DM; c += NWAVES * 64) {
            tab[c] = args.kv_norm_g[c] * (1.0f + mkv[DM + c]); tab[DM + c] = mkv[c];
            tab[2 * DM + c] = args.b_norm_g[c] * (1.0f + mb[DM + c]); tab[3 * DM + c] = mb[c]; }
        __syncthreads();
        norm_mod_rows<2>(F, (const float*)(ws + WS_H1), (bf16*)(ws + WS_KVN), (bf16*)(ws + WS_HNB), tab);
        if (BOTH(6)) GRID_BAR();
    }
    if (IN(7)) {
        pg8::Gemm g{(const pg8::bf16_t*)(ws + WS_KVN), (const pg8::bf16_t*)(ws + WS_W_KVQG), S_, 4 * AW, DM, DM, DM, 32, (long)(WS_HNB - WS_KVN)};
        pg8::StaticOrder S; S.init(S_, 4 * AW, F.G, (int)blockIdx.x);
        pg8::EpiKVQZ E{(pg8::bf16_t*)(ws + WS_K), (size_t)(WS_V - WS_K) / 2, (const float*)(ws + WS_COS), (const float*)(ws + WS_SIN)};
        pg8::gemm_phase<pg8::EpiKVQZ, pg8::StaticOrder, true, true>(F.lds + RING_OFF, g, S, E);
        if (BOTH(7)) GRID_BAR();
    }
    if (IN(8)) {
        const att::bf16* Q = (const att::bf16*)(ws + WS_Q); const att::bf16* Kt = (const att::bf16*)(ws + WS_K); const att::bf16* V = (const att::bf16*)(ws + WS_V); att::bf16* OC = (att::bf16*)(ws + WS_OC);
        const int npair = 64 * 16;
        for (int pi = F.vcu; pi < npair; pi += F.G) {
            const int combo = pi >> 4, p = pi & 15, hh = combo >> 1, vh = combo & 1, h = hh >> 1, c = hh & 1;
#pragma unroll 1
            for (int s = 0; s < 2; ++s) {
                const int qb = s ? p : 31 - p, q0 = qb * 256;
                att::attn_unit(Q + (size_t)q0 * AW + hh * DH, Kt + hh * DH, V + h * 256 + vh * 128,
                               OC + (size_t)q0 * (2 * AW) + c * AW + h * 256 + vh * 128, 4 * qb + 4, 4 * qb + (F.wave >> 1), (char*)lds + RING_OFF);
            }
        }
        if (BOTH(8)) GRID_BAR();
    }
    if (IN(9)) { p9_combine(F, args); if (BOTH(9)) GRID_BAR(); }
    if (IN(10)) {
        pg8::Gemm g{(const pg8::bf16_t*)(ws + WS_YB), (const pg8::bf16_t*)(ws + WS_W_OUTB), S_, DM, AW, AW, AW, 1 << 20, 0};
        pg8::StaticOrder S; S.init(S_, DM, F.G, (int)blockIdx.x);
        pg8::EpiResid E{(const float*)(ws + WS_H1), args.out, DM, mall + 20480 + 2 * DM};
        pg8::gemm_phase<pg8::EpiResid, pg8::StaticOrder, true, true>(F.lds + RING_OFF, g, S, E);
        if (BOTH(10)) GRID_BAR();
    }
    if (IN(11)) { p11_final(F, args); }
#undef IN
#undef BOTH
#undef GRID_BAR
}

extern "C" void kernel_launch(void* const* d_in, const int* in_sizes, int n_in, void* d_out, int out_size, void* d_ws, size_t ws_size, hipStream_t stream) {
    static int grid = 0;
    if (grid == 0) {
        if (n_in != 22 || in_sizes[0] != S_ * DM || out_size != S_ * DM || ws_size < WS_END) {
            fprintf(stderr, "kernel_launch: shape mismatch: n_in %d in0 %d out %d ws %zu (need %zu)\n", n_in, n_in > 0 ? in_sizes[0] : -1, out_size, ws_size, (size_t)WS_END); grid = -1; return; }
        int dev = 0, cus = 0, per_cu = 0;
        if (hipGetDevice(&dev) != hipSuccess || hipDeviceGetAttribute(&cus, hipDeviceAttributeMultiprocessorCount, dev) != hipSuccess) { fprintf(stderr, "kernel_launch: device query failed\n"); grid = -1; return; }
        if (hipFuncSetAttribute((const void*)yoco_fwd, hipFuncAttributeMaxDynamicSharedMemorySize, LDS_BYTES) != hipSuccess) { fprintf(stderr, "kernel_launch: hipFuncSetAttribute failed\n"); grid = -1; return; }
        if (hipOccupancyMaxActiveBlocksPerMultiprocessor(&per_cu, (const void*)yoco_fwd, NWAVES * 64, LDS_BYTES) != hipSuccess || per_cu < 1)
            fprintf(stderr, "kernel_launch: occupancy query reports %d workgroups per CU\n", per_cu);
        (void)hipGetLastError();
        grid = cus;
    }
    if (grid < 0) return;
    if (hipMemsetAsync((char*)d_ws + WS_CTL, 0, CTL_ZERO_BYTES, stream) != hipSuccess) { fprintf(stderr, "kernel_launch: memset failed\n"); return; }
    Args a{};
    a.x = (const float*)d_in[0]; a.c = (const float*)d_in[1]; a.pos = (const int*)d_in[2];
    a.a_norm_g = (const float*)d_in[3]; a.a_ada_w = (const float*)d_in[4]; a.a_ada_b = (const float*)d_in[5]; a.a_w_in = (const float*)d_in[6]; a.a_w_group = (const float*)d_in[7];
    a.a_scale = (const float*)d_in[8]; a.a_w_out = (const float*)d_in[9];
    a.kv_norm_g = (const float*)d_in[10]; a.kv_ada_w = (const float*)d_in[11]; a.kv_ada_b = (const float*)d_in[12]; a.w_kv = (const float*)d_in[13];
    a.b_norm_g = (const float*)d_in[14]; a.b_ada_w = (const float*)d_in[15]; a.b_ada_b = (const float*)d_in[16]; a.b_w_qg = (const float*)d_in[17]; a.b_lam = (const float*)d_in[18];
    a.b_subln_g = (const float*)d_in[19]; a.b_w_out = (const float*)d_in[20]; a.final_g = (const float*)d_in[21];
    a.out = (float*)d_out; a.ws = (unsigned char*)d_ws;
    for (int li = 0; li < N_LAUNCHES; ++li) {
        a.ph_lo = (N_LAUNCHES == 1) ? 0 : li; a.ph_hi = (N_LAUNCHES == 1) ? N_PHASES : li + 1; a.li = li; a.pad = 0;
        hipLaunchKernelGGL(yoco_fwd, dim3(grid), dim3(NWAVES * 64), LDS_BYTES, stream, a);
        const hipError_t le = hipPeekAtLastError();
        if (le != hipSuccess) { fprintf(stderr, "kernel_launch: launch %d failed: %s\n", li, hipGetErrorName(le)); break; }
    }
}
```

```cpp
#include <hip/hip_runtime.h>
#include <hip/hip_bf16.h>
#include <cstdio>
#include <cstdint>
#include <cmath>

#ifndef MK_N_LAUNCHES
#define MK_N_LAUNCHES 1
#endif
constexpr int N_PHASES = 12;
#ifndef PROBE_DUP
#define PROBE_DUP -1
#endif
constexpr int N_LAUNCHES = MK_N_LAUNCHES;

namespace pg8 {
#define PG8_LAS __attribute__((address_space(3)))
typedef unsigned short bf16_t;
typedef short bf16x8 __attribute__((ext_vector_type(8)));
typedef float f32x4 __attribute__((ext_vector_type(4)));
typedef float f32x2 __attribute__((ext_vector_type(2)));
typedef unsigned u32x4 __attribute__((ext_vector_type(4)));
constexpr int BM = 256, BK = 64, HALF = 128, HTB = HALF * BK * 2, STAGE_BYTES = 8 * HTB, NXCD = 8, WGM = 8;

__host__ __device__ __forceinline__ int lds_byte(int r, int c) { const int st = (r >> 4) * 2 + (c >> 5), rr = r & 15, cc = c & 31, ob = rr * 64 + cc * 2; return st * 1024 + (ob ^ (((ob >> 9) & 1) << 5)); }
__host__ __device__ __forceinline__ void stage_rc(int b, int& R, int& C) { const int st = b / 1024, sb = b % 1024, swz = sb ^ (((sb >> 9) & 1) << 5); R = (st >> 1) * 16 + swz / 64; C = (st & 1) * 32 + (swz % 64) / 2; }
__host__ __device__ __forceinline__ int perm32(int rho) { const int n = rho >> 4, i = rho & 15; return 8 * (i >> 2) + 4 * n + (i & 3); }

struct Unit { int pm, pn; };
struct Gemm { const bf16_t* A; const bf16_t* Bt; int M, N, K, lda, ldb, adiv; long astride; };

struct StaticOrder {
    int nM, nN, nwg, G, c;
    __host__ __device__ void init(int M, int N, int G_, int c_) { nM = M / BM; nN = N / BM; nwg = nM * nN; G = G_; c = c_; }
    __host__ __device__ bool next(int i, Unit& u) const {
        const long L = (long)i * G + c; if (L >= nwg) return false;
        int wgid = (int)L; { const int q = nwg / NXCD, r = nwg % NXCD, xcd = wgid % NXCD, off = wgid / NXCD; wgid = (xcd < r ? xcd * (q + 1) : r * (q + 1) + (xcd - r) * q) + off; }
        const int nig = WGM * nN, gid = wgid / nig, fm = gid * WGM, gsz = (nM - fm) < WGM ? (nM - fm) : WGM;
        u.pm = fm + ((wgid % nig) % gsz); u.pn = (wgid % nig) / gsz; return true;
    }
    __device__ __forceinline__ void a_ready(const Unit&) const {}
    __device__ __forceinline__ void done(const Unit&) const {}
};

__device__ __forceinline__ unsigned cvt_pk_bf16(float lo, float hi) { unsigned r; asm volatile("v_cvt_pk_bf16_f32 %0, %1, %2" : "=v"(r) : "v"(lo), "v"(hi)); return r; }
__device__ __forceinline__ float bf_lo(unsigned u) { return __uint_as_float(u << 16); }
__device__ __forceinline__ float bf_hi(unsigned u) { return __uint_as_float(u & 0xffff0000u); }
__device__ __forceinline__ float silu_f(float z) { return z * __builtin_amdgcn_rcpf(1.0f + __builtin_amdgcn_exp2f(-1.4426950408889634f * z)); }


struct EpiBf16 {
    static constexpr bool PERM = true;
    bf16_t* O; int ldc;
    __device__ __forceinline__ void operator()(const f32x4 (&acc)[2][2][4][2], const Unit& u, int wr, int wc, int fr, int fq) const {
        const int row0 = u.pm * BM + wr * 64 + fr, col0 = u.pn * BM + wc * 32 + 8 * fq;
#pragma unroll
        for (int ai = 0; ai < 2; ++ai)
#pragma unroll
            for (int m = 0; m < 4; ++m) { bf16_t* rowp = O + (size_t)(row0 + ai * HALF + m * 16) * ldc + col0;
#pragma unroll
                for (int bj = 0; bj < 2; ++bj) { const f32x4 v0 = acc[ai][bj][m][0], v1 = acc[ai][bj][m][1];
                    u32x4 w; w.x = cvt_pk_bf16(v0[0], v0[1]); w.y = cvt_pk_bf16(v0[2], v0[3]); w.z = cvt_pk_bf16(v1[0], v1[1]); w.w = cvt_pk_bf16(v1[2], v1[3]);
                    *(u32x4*)(rowp + bj * HALF) = w; } }
    }
};
struct EpiNull {
    static constexpr bool PERM = true;
    __device__ __forceinline__ void operator()(const f32x4 (&acc)[2][2][4][2], const Unit&, int, int, int, int) const {
#pragma unroll
        for (int ai = 0; ai < 2; ++ai)
#pragma unroll
            for (int bj = 0; bj < 2; ++bj)
#pragma unroll
                for (int m = 0; m < 4; ++m)
#pragma unroll
                    for (int n = 0; n < 2; ++n) { f32x4 v = acc[ai][bj][m][n]; asm volatile("" :: "v"(v)); }
    }
};
struct EpiPoolY {
    static constexpr bool PERM = true;
    bf16_t* O; int ldc; const float* cscale; const bf16_t* Z; int ldz;
    __device__ __forceinline__ void operator()(const f32x4 (&acc)[2][2][4][2], const Unit& u, int wr, int wc, int fr, int fq) const {
        const int row0 = u.pm * BM + wr * 64 + fr, col0 = u.pn * BM + wc * 32 + 8 * fq;
        f32x4 sv[2][2];
#pragma unroll
        for (int bj = 0; bj < 2; ++bj)
#pragma unroll
            for (int n = 0; n < 2; ++n) sv[bj][n] = *(const f32x4*)(cscale + col0 + bj * HALF + 4 * n);
#pragma unroll
        for (int ai = 0; ai < 2; ++ai)
#pragma unroll
            for (int m = 0; m < 4; ++m) { const size_t r = (size_t)(row0 + ai * HALF + m * 16); bf16_t* rowp = O + r * ldc + col0; const bf16_t* zp = Z + r * ldz + col0;
#pragma unroll
                for (int bj = 0; bj < 2; ++bj) { const u32x4 zz = *(const u32x4*)(zp + bj * HALF);
                    const f32x4 v0 = acc[ai][bj][m][0] * sv[bj][0], v1 = acc[ai][bj][m][1] * sv[bj][1];
                    u32x4 w;
                    w.x = cvt_pk_bf16(v0[0] * silu_f(bf_lo(zz.x)), v0[1] * silu_f(bf_hi(zz.x)));
                    w.y = cvt_pk_bf16(v0[2] * silu_f(bf_lo(zz.y)), v0[3] * silu_f(bf_hi(zz.y)));
                    w.z = cvt_pk_bf16(v1[0] * silu_f(bf_lo(zz.z)), v1[1] * silu_f(bf_hi(zz.z)));
                    w.w = cvt_pk_bf16(v1[2] * silu_f(bf_lo(zz.w)), v1[3] * silu_f(bf_hi(zz.w)));
                    *(u32x4*)(rowp + bj * HALF) = w; } }
    }
};
struct EpiResid {
    static constexpr bool PERM = false;
    const float* base; float* out; int ldc; const float* gate;
    __device__ __forceinline__ void operator()(const f32x4 (&acc)[2][2][4][2], const Unit& u, int wr, int wc, int fr, int fq) const {
        const int row0 = u.pm * BM + wr * 64 + fr, col0 = u.pn * BM + wc * 32 + 4 * fq;
        f32x4 gv[2][2];
#pragma unroll
        for (int bj = 0; bj < 2; ++bj)
#pragma unroll
            for (int n = 0; n < 2; ++n) gv[bj][n] = *(const f32x4*)(gate + col0 + bj * HALF + n * 16);
#pragma unroll
        for (int ai = 0; ai < 2; ++ai)
#pragma unroll
            for (int m = 0; m < 4; ++m) { const size_t off = (size_t)(row0 + ai * HALF + m * 16) * ldc + col0;
#pragma unroll
                for (int bj = 0; bj < 2; ++bj)
#pragma unroll
                    for (int n = 0; n < 2; ++n) { const f32x4 b = *(const f32x4*)(base + off + bj * HALF + n * 16);
                        *(f32x4*)(out + off + bj * HALF + n * 16) = b + gv[bj][n] * acc[ai][bj][m][n]; } }
    }
};
struct EpiKVQZ {
    static constexpr bool PERM = true;
    bf16_t* O; size_t tstride; int ldz; int S; const float* cs; const float* sn;
    __device__ __forceinline__ void operator()(const f32x4 (&acc)[2][2][4][2], const Unit& u, int wr, int wc, int fr, int fq) const {
        const int t = u.pn >> 4, pt = u.pn & 15; const bool rot = (t == 0) || (t == 2);
        const int row0 = u.pm * BM + wr * 64 + fr, cw = wc * 32 + 8 * fq, i0 = wc * 16 + 4 * fq;
        bf16_t* base = O + (size_t)t * tstride;
#pragma unroll
        for (int ai = 0; ai < 2; ++ai)
#pragma unroll
            for (int m = 0; m < 4; ++m) { const int row = row0 + ai * HALF + m * 16;
                f32x4 c4 = (f32x4){1.f, 1.f, 1.f, 1.f}, s4 = (f32x4){0.f, 0.f, 0.f, 0.f};
                if (rot) { c4 = *(const f32x4*)(cs + (size_t)row * 64 + i0); s4 = *(const f32x4*)(sn + (size_t)row * 64 + i0); }
#pragma unroll
                for (int bj = 0; bj < 2; ++bj) { const f32x4 v0 = acc[ai][bj][m][0], v1 = acc[ai][bj][m][1];
                    u32x4 w;
                    w.x = cvt_pk_bf16(v0[0] * c4[0] - v0[1] * s4[0], v0[1] * c4[0] + v0[0] * s4[0]);
                    w.y = cvt_pk_bf16(v0[2] * c4[1] - v0[3] * s4[1], v0[3] * c4[1] + v0[2] * s4[1]);
                    w.z = cvt_pk_bf16(v1[0] * c4[2] - v1[1] * s4[2], v1[1] * c4[2] + v1[0] * s4[2]);
                    w.w = cvt_pk_bf16(v1[2] * c4[3] - v1[3] * s4[3], v1[3] * c4[3] + v1[2] * s4[3]);
                    bf16_t* dst;
                    if (t == 3) dst = base + (size_t)row * ldz + pt * BM + bj * HALF + cw;
                    else if (t == 1) dst = base + ((size_t)pt * S + row) * 256 + bj * HALF + cw;
                    else dst = base + ((size_t)(pt * 2 + bj) * S + row) * 128 + cw;
                    *(u32x4*)dst = w; } }
    }
};

template <class Epi, class Sched, bool ALIGN_EPI = false, bool SP2 = false>
__device__ __forceinline__ void gemm_phase(PG8_LAS unsigned char* lds, const Gemm g, const Sched& S, const Epi& E) {
    const int tid = threadIdx.x, wid = __builtin_amdgcn_readfirstlane(tid >> 6), lane = tid & 63, wr = wid >> 2, wc = wid & 3, fr = lane & 15, fq = lane >> 4;
    const int K = g.K, nt = K / BK;
    unsigned voffA[2], voffB[2];
#pragma unroll
    for (int i = 0; i < 2; ++i) { int R, C; stage_rc(tid * 16 + i * 8192, R, C); const int Rb = Epi::PERM ? ((R & ~31) + perm32(R & 31)) : R;
        voffA[i] = (unsigned)(R * g.lda + C) * 2u; voffB[i] = (unsigned)(Rb * g.ldb + C) * 2u; }
    const size_t kstep = (size_t)(BK * 2);
    const size_t hstepA = (size_t)HALF * g.lda * 2, hstepB = (size_t)HALF * g.ldb * 2;
    const unsigned ldsw = (unsigned)wid * 1024u;
    const int aoff = lds_byte(wr * 64 + fr, fq * 8), boff = lds_byte(wc * 32 + fr, fq * 8);
#define PG8_UA(u) ((const char*)g.A + (size_t)(u).pm * 2 * hstepA + (size_t)((u).pn / g.adiv) * (size_t)g.astride)
#define PG8_UB(u) ((const char*)g.Bt + (size_t)(u).pn * 2 * hstepB)
#define PG8_SA(b, h) (((b) * 2 + (h)) * HTB)
#define PG8_SB(b, h) ((4 + (b) * 2 + (h)) * HTB)
#define PG8_STAGE(bufoff, gbase, voff) do { _Pragma("unroll") for (int _i = 0; _i < 2; ++_i) \
        __builtin_amdgcn_global_load_lds((const unsigned*)((const char*)(gbase) + (voff)[_i]), (PG8_LAS unsigned*)(lds + (bufoff) + ldsw + _i * 8192), 16, 0, 0); } while (0)
#define PG8_LDA(dst, b, h) do { _Pragma("unroll") for (int m = 0; m < 4; ++m) _Pragma("unroll") for (int k = 0; k < 2; ++k) dst[m][k] = *(const PG8_LAS bf16x8*)(lds + PG8_SA(b, h) + aoff + m * 2048 + k * 1024); } while (0)
#define PG8_LDB(dst, b, h) do { _Pragma("unroll") for (int n = 0; n < 2; ++n) _Pragma("unroll") for (int k = 0; k < 2; ++k) dst[n][k] = *(const PG8_LAS bf16x8*)(lds + PG8_SB(b, h) + boff + n * 2048 + k * 1024); } while (0)
#define PG8_MMA(ai, bj, At, Bt) do { __builtin_amdgcn_s_setprio(1); _Pragma("unroll") for (int m = 0; m < 4; ++m) _Pragma("unroll") for (int n = 0; n < 2; ++n) _Pragma("unroll") for (int k = 0; k < 2; ++k) \
        acc[ai][bj][m][n] = __builtin_amdgcn_mfma_f32_16x16x32_bf16(Bt[n][k], At[m][k], acc[ai][bj][m][n], 0, 0, 0); __builtin_amdgcn_s_setprio(0); } while (0)
#define PG8_WAIT_V(n) asm volatile("s_waitcnt vmcnt(" #n ")" ::: "memory")
#define PG8_WAIT_L(n) asm volatile("s_waitcnt lgkmcnt(" #n ")" ::: "memory")
#define PG8_BAR __builtin_amdgcn_s_barrier()
#define PG8_SCHED __builtin_amdgcn_sched_barrier(0)
    Unit cur, nxt; int ui = 0;
    if (!S.next(0, cur)) return;
    f32x4 acc[2][2][4][2];
#pragma unroll
    for (int a = 0; a < 2; ++a)
#pragma unroll
        for (int b = 0; b < 2; ++b)
#pragma unroll
            for (int m = 0; m < 4; ++m)
#pragma unroll
                for (int n = 0; n < 2; ++n) acc[a][b][m][n] = (f32x4){0.f, 0.f, 0.f, 0.f};
    bf16x8 At[4][2], B0[2][2], B1[2][2];
    const char* cA = PG8_UA(cur); const char* cB = PG8_UB(cur);
    S.a_ready(cur);
    if constexpr (SP2) {
        PG8_STAGE(PG8_SB(0, 0), cB, voffB); PG8_STAGE(PG8_SB(0, 1), cB + hstepB, voffB); PG8_STAGE(PG8_SA(0, 0), cA, voffA); PG8_STAGE(PG8_SA(0, 1), cA + hstepA, voffA);
        if (wr == 1) PG8_BAR;
        PG8_WAIT_V(2); PG8_BAR;
        PG8_STAGE(PG8_SB(1, 0), cB + kstep, voffB); PG8_STAGE(PG8_SA(1, 0), cA + kstep, voffA); PG8_STAGE(PG8_SB(1, 1), cB + hstepB + kstep, voffB);
        PG8_WAIT_V(6); PG8_BAR;
    } else {
        PG8_STAGE(PG8_SB(0, 0), cB, voffB); PG8_STAGE(PG8_SA(0, 0), cA, voffA); PG8_STAGE(PG8_SB(0, 1), cB + hstepB, voffB); PG8_STAGE(PG8_SA(0, 1), cA + hstepA, voffA);
        if (wr == 1) PG8_BAR;
        PG8_WAIT_V(4); PG8_BAR;
        PG8_STAGE(PG8_SB(1, 0), cB + kstep, voffB); PG8_STAGE(PG8_SA(1, 0), cA + kstep, voffA); PG8_STAGE(PG8_SB(1, 1), cB + hstepB + kstep, voffB);
        PG8_WAIT_V(6); PG8_BAR;
    }
    for (;;) {
        const bool has_next = S.next(ui + 1, nxt);
        const char* nA = has_next ? PG8_UA(nxt) : cA; const char* nB = has_next ? PG8_UB(nxt) : cB;
        for (int t = 0; t < nt; t += 2) {
            const bool last = (t == nt - 2);
            const char* a1 = cA + (size_t)(t + 1) * kstep;
            const char* a2 = last ? nA : cA + (size_t)(t + 2) * kstep; const char* b2 = last ? nB : cB + (size_t)(t + 2) * kstep;
            const char* a3 = a2 + kstep; const char* b3 = b2 + kstep;
            if (last && has_next) S.a_ready(nxt);
            if constexpr (SP2) {
            PG8_LDB(B0, 0, 0); PG8_LDB(B1, 0, 1); PG8_SCHED; PG8_LDA(At, 0, 0); PG8_STAGE(PG8_SA(1, 1), a1 + hstepA, voffA);
            PG8_WAIT_V(8); PG8_WAIT_L(0); PG8_BAR; PG8_MMA(0, 0, At, B0); PG8_MMA(0, 1, At, B1); PG8_BAR; PG8_SCHED;
            PG8_LDA(At, 0, 1); PG8_STAGE(PG8_SB(0, 0), b2, voffB); PG8_STAGE(PG8_SB(0, 1), b2 + hstepB, voffB); PG8_STAGE(PG8_SA(0, 0), a2, voffA);
            PG8_WAIT_V(8); PG8_WAIT_L(0); PG8_BAR; PG8_MMA(1, 0, At, B0); PG8_MMA(1, 1, At, B1); PG8_BAR; PG8_SCHED;
            PG8_LDB(B0, 1, 0); PG8_LDB(B1, 1, 1); PG8_SCHED; PG8_LDA(At, 1, 0); PG8_STAGE(PG8_SA(0, 1), a2 + hstepA, voffA);
            PG8_WAIT_V(8); PG8_WAIT_L(0); PG8_BAR; PG8_MMA(0, 0, At, B0); PG8_MMA(0, 1, At, B1); PG8_BAR; PG8_SCHED;
            PG8_LDA(At, 1, 1); PG8_STAGE(PG8_SB(1, 0), b3, voffB); PG8_STAGE(PG8_SB(1, 1), b3 + hstepB, voffB); PG8_STAGE(PG8_SA(1, 0), a3, voffA);
            PG8_WAIT_V(8); PG8_WAIT_L(0); PG8_BAR; PG8_MMA(1, 0, At, B0); PG8_MMA(1, 1, At, B1); PG8_BAR; PG8_SCHED;
            } else {
            PG8_LDB(B0, 0, 0); PG8_SCHED; PG8_LDA(At, 0, 0); PG8_STAGE(PG8_SA(1, 1), a1 + hstepA, voffA);
            PG8_WAIT_L(8); PG8_BAR; PG8_WAIT_L(0); PG8_MMA(0, 0, At, B0); PG8_BAR; PG8_SCHED;
            PG8_LDB(B1, 0, 1); PG8_STAGE(PG8_SB(0, 0), b2, voffB);
            PG8_BAR; PG8_WAIT_L(0); PG8_MMA(0, 1, At, B1); PG8_BAR;
            PG8_LDA(At, 0, 1); PG8_STAGE(PG8_SA(0, 0), a2, voffA);
            PG8_BAR; PG8_WAIT_L(0); PG8_MMA(1, 0, At, B0); PG8_BAR; PG8_SCHED;
            PG8_STAGE(PG8_SB(0, 1), b2 + hstepB, voffB);
            PG8_WAIT_V(6); PG8_BAR; PG8_MMA(1, 1, At, B1); PG8_BAR;
            PG8_LDB(B0, 1, 0); PG8_SCHED; PG8_LDA(At, 1, 0); PG8_STAGE(PG8_SA(0, 1), a2 + hstepA, voffA);
            PG8_WAIT_L(8); PG8_BAR; PG8_WAIT_L(0); PG8_MMA(0, 0, At, B0); PG8_BAR; PG8_SCHED;
            PG8_LDB(B1, 1, 1); PG8_STAGE(PG8_SB(1, 0), b3, voffB);
            PG8_BAR; PG8_WAIT_L(0); PG8_MMA(0, 1, At, B1); PG8_BAR;
            PG8_LDA(At, 1, 1); PG8_STAGE(PG8_SA(1, 0), a3, voffA);
            PG8_BAR; PG8_WAIT_L(0); PG8_MMA(1, 0, At, B0); PG8_BAR; PG8_SCHED;
            PG8_STAGE(PG8_SB(1, 1), b3 + hstepB, voffB);
            PG8_WAIT_V(6); PG8_BAR; PG8_MMA(1, 1, At, B1); PG8_BAR;
            }
        }
        if constexpr (ALIGN_EPI) { if (wr == 0) PG8_BAR; }
        E(acc, cur, wr, wc, fr, fq); S.done(cur);
        if (!has_next) break;
#pragma unroll
        for (int a = 0; a < 2; ++a)
#pragma unroll
            for (int b = 0; b < 2; ++b)
#pragma unroll
                for (int m = 0; m < 4; ++m)
#pragma unroll
                    for (int n = 0; n < 2; ++n) acc[a][b][m][n] = (f32x4){0.f, 0.f, 0.f, 0.f};
        cur = nxt; cA = nA; cB = nB; ++ui;
        if constexpr (ALIGN_EPI) { if (wr == 1) PG8_BAR; }
    }
    PG8_WAIT_V(0);
    if constexpr (!ALIGN_EPI) { if (wr == 0) PG8_BAR; }
    PG8_BAR;
#undef PG8_UA
#undef PG8_UB
#undef PG8_SA
#undef PG8_SB
#undef PG8_STAGE
#undef PG8_LDA
#undef PG8_LDB
#undef PG8_MMA
#undef PG8_WAIT_V
#undef PG8_WAIT_L
#undef PG8_BAR
#undef PG8_SCHED
}
}

namespace atty {
using bf16 = __hip_bfloat16;
using bf16x8 = __attribute__((ext_vector_type(8))) short;
using s16x4  = __attribute__((ext_vector_type(4))) short;
using f32x16 = __attribute__((ext_vector_type(16))) float;
using u32x4  = __attribute__((ext_vector_type(4))) unsigned;
#define ATY_LAS __attribute__((address_space(3)))
constexpr int QBLK = 32, KVBLK = 64, UROWS = 128;
constexpr float SCALE = 0.088388347648318440f;
constexpr float THR = 8.f;
constexpr int LDQ = 128, LDK = 128, LDV = 256, LDO = 8192;
constexpr int KBUF = 16384, VBUF = 32768, PBUF = 16384;
constexpr int LDS_K = 0, LDS_V = 2 * KBUF, LDS_P = LDS_V + 2 * VBUF, LDS_AL = LDS_P + 2 * PBUF, LDS_LI = LDS_AL + 2 * 4 * 128, LDS_END = LDS_LI + 4 * 128;
#define SBAR() __builtin_amdgcn_sched_barrier(0)
__device__ __forceinline__ int crow(int r, int hi) { return (r & 3) + 8 * (r >> 2) + 4 * hi; }
__device__ __forceinline__ unsigned cvtpk(float lo, float hi) { unsigned r; asm volatile("v_cvt_pk_bf16_f32 %0, %1, %2" : "=v"(r) : "v"(lo), "v"(hi)); return r; }
__device__ __forceinline__ unsigned rfl(unsigned v) { return (unsigned)__builtin_amdgcn_readfirstlane((int)v); }
__device__ __forceinline__ void dma16(unsigned m0v, int voff, __amdgpu_buffer_rsrc_t srd, unsigned soff) {
  unsigned keep;
  asm volatile("s_nop 4\n\ts_mov_b32 %0, m0\n\ts_mov_b32 m0, %1\n\ts_nop 0\n\tbuffer_load_dwordx4 %2, %3, %4 offen lds\n\ts_mov_b32 m0, %0"
               : "=&s"(keep) : "s"(m0v), "v"(voff), "s"(srd), "s"(soff) : "memory");
}
constexpr int v_rd_off(int d0, int ks, int half) { return d0 * 512 + ks * 4096 + half * 2048; }
__device__ __forceinline__ int v_rd_base(int lane) { return ((lane & 3) << 3) | (((lane >> 2) & 3) << 6) | (((lane >> 4) & 1) << 5) | (((lane >> 5) & 1) << 8); }
template <int OFF> __device__ __forceinline__ s16x4 tr_read(int vb) {
  s16x4 r; asm volatile("ds_read_b64_tr_b16 %0, %1 offset:%2" : "=&v"(r) : "v"(vb), "i"(OFF) : "memory"); return r;
}
template <int BASE> __device__ __forceinline__ void pv_one(f32x16& od, int vb, bf16x8 pa0, bf16x8 pa1, bf16x8 pa2, bf16x8 pa3) {
  const s16x4 l0 = tr_read<BASE + v_rd_off(0, 0, 0)>(vb), h0 = tr_read<BASE + v_rd_off(0, 0, 1)>(vb), l1 = tr_read<BASE + v_rd_off(0, 1, 0)>(vb), h1 = tr_read<BASE + v_rd_off(0, 1, 1)>(vb);
  const s16x4 l2 = tr_read<BASE + v_rd_off(0, 2, 0)>(vb), h2 = tr_read<BASE + v_rd_off(0, 2, 1)>(vb), l3 = tr_read<BASE + v_rd_off(0, 3, 0)>(vb), h3 = tr_read<BASE + v_rd_off(0, 3, 1)>(vb);
  asm volatile("s_waitcnt lgkmcnt(0)" ::: "memory"); SBAR();
#define PK(L, H) (bf16x8){L[0], L[1], L[2], L[3], H[0], H[1], H[2], H[3]}
  od = __builtin_amdgcn_mfma_f32_32x32x16_bf16(pa0, PK(l0, h0), od, 0, 0, 0);
  od = __builtin_amdgcn_mfma_f32_32x32x16_bf16(pa1, PK(l1, h1), od, 0, 0, 0);
  od = __builtin_amdgcn_mfma_f32_32x32x16_bf16(pa2, PK(l2, h2), od, 0, 0, 0);
  od = __builtin_amdgcn_mfma_f32_32x32x16_bf16(pa3, PK(l3, h3), od, 0, 0, 0);
#undef PK
}

__device__ __forceinline__ void attn_unit(const bf16* __restrict__ Qb, const bf16* __restrict__ Kh, const bf16* __restrict__ Vh, bf16* __restrict__ Ob, int NT, int jw, ATY_LAS unsigned char* lds) {
  const int tid = threadIdx.x, lane = tid & 63, r32 = lane & 31, hi = lane >> 5;
  const int wid = __builtin_amdgcn_readfirstlane(tid >> 6), grp = wid & 3; const bool swave = wid < 4;
  const unsigned lds0 = (unsigned)(uintptr_t)lds;
  const __amdgpu_buffer_rsrc_t srdK = __builtin_amdgcn_make_buffer_rsrc((void*)Kh, 0, 0x7fffffff, 0x00020000), srdV = __builtin_amdgcn_make_buffer_rsrc((void*)Vh, 0, 0x7fffffff, 0x00020000);
  int kvo[2], vvo[4];
#pragma unroll
  for (int e = 0; e < 2; ++e) { const int row = 8 * wid + 4 * e + (lane >> 4), ch = (lane & 15) ^ (row & 7); kvo[e] = (row * LDK + ch * 8) * 2; }
#pragma unroll
  for (int e = 0; e < 4; ++e) { const int pj = 4 * wid + e, hv = pj >> 4, j = pj & 15, sb = 2 * j + (lane >> 5), kk = (sb >> 2) * 8 + ((lane & 31) >> 2), c = (sb & 3) * 32 + (lane & 3) * 8;
    const int k = (kk & ~0xC) | ((kk & 4) << 1) | ((kk & 8) >> 1); vvo[e] = (k * LDV + hv * 128 + c) * 2; }
#define DMA_K(t, buf) do { _Pragma("unroll") for (int e_ = 0; e_ < 2; ++e_) dma16(rfl(lds0 + LDS_K + (unsigned)(buf) * KBUF + (unsigned)(2 * wid + e_) * 1024u), kvo[e_], srdK, rfl((unsigned)(t) * (KVBLK * LDK * 2))); } while (0)
#define DMA_V(t, buf) do { _Pragma("unroll") for (int e_ = 0; e_ < 4; ++e_) dma16(rfl(lds0 + LDS_V + (unsigned)(buf) * VBUF + (unsigned)(4 * wid + e_) * 1024u), vvo[e_], srdV, rfl((unsigned)(t) * (KVBLK * LDV * 2))); } while (0)
#define WAITV_BAR() asm volatile("s_waitcnt vmcnt(0) lgkmcnt(0)\n\ts_barrier" ::: "memory")
  DMA_K(0, 0);
  const unsigned pofs = lds0 + LDS_P + (unsigned)grp * 4096u + (unsigned)lane * 16u;
  ATY_LAS float* al_l = (ATY_LAS float*)(lds + LDS_AL) + grp * 32;
  ATY_LAS float* li_l = (ATY_LAS float*)(lds + LDS_LI) + grp * 32;
  if (swave) {
    bf16x8 qr[8];
    { const __amdgpu_buffer_rsrc_t srdQ = __builtin_amdgcn_make_buffer_rsrc((void*)Qb, 0, 0x7fffffff, 0x00020000);
      const int qoff = ((grp * QBLK + r32) * LDQ + hi * 8) * 2;
#pragma unroll
      for (int d0 = 0; d0 < 8; ++d0) qr[d0] = __builtin_bit_cast(bf16x8, __builtin_amdgcn_raw_buffer_load_b128(srdQ, qoff + d0 * 32, 0, 0)); }
    unsigned kp0[4];
#pragma unroll
    for (int dd = 0; dd < 4; ++dd) kp0[dd] = lds0 + LDS_K + (unsigned)(r32 * 256 + (((dd * 16 + hi * 8) * 2) ^ ((r32 & 7) << 4)));
    float m_reg = -1e30f, l_reg = 0.f;
#pragma unroll
    for (int d0 = 0; d0 < 8; ++d0) asm volatile("" : "+v"(qr[d0]));
    WAITV_BAR();
#pragma unroll 1
    for (int i = 0; i <= NT; ++i) {
      if (i + 1 < NT) DMA_K(i + 1, (i + 1) & 1);
      if (i < NT) DMA_V(i, i & 1);
      if (i < NT && i <= jw) {
        const unsigned kofs = (unsigned)(i & 1) * KBUF;
        f32x16 p0 = f32x16{}, p1 = f32x16{};
#pragma unroll
        for (int d0 = 0; d0 < 8; ++d0) { const unsigned a = kp0[d0 & 3] + kofs + (d0 >> 2) * 128;
          const bf16x8 b0 = *(const ATY_LAS bf16x8*)(uintptr_t)a; const bf16x8 b1 = *(const ATY_LAS bf16x8*)(uintptr_t)(a + 8192);
          p0 = __builtin_amdgcn_mfma_f32_32x32x16_bf16(b0, qr[d0], p0, 0, 0, 0);
          p1 = __builtin_amdgcn_mfma_f32_32x32x16_bf16(b1, qr[d0], p1, 0, 0, 0); }
        constexpr float C = SCALE * 1.4426950408889634f;
        float pmax = p0[0];
#pragma unroll
        for (int r = 1; r < 16; ++r) pmax = fmaxf(pmax, p0[r]);
#pragma unroll
        for (int r = 0; r < 16; ++r) pmax = fmaxf(pmax, p1[r]);
        { auto rr = __builtin_amdgcn_permlane32_swap(__float_as_uint(pmax), __float_as_uint(pmax), false, false);
          pmax = fmaxf(__uint_as_float(rr[0]), __uint_as_float(rr[1])); }
        float mn, alpha;
        if (__builtin_expect(__all(pmax - m_reg <= THR / SCALE), 1)) { mn = m_reg; alpha = 1.f; }
        else { mn = fmaxf(m_reg, pmax); alpha = __builtin_amdgcn_exp2f((m_reg - mn) * C); m_reg = mn; }
        const float mnC = -mn * C;
#pragma unroll
        for (int r = 0; r < 16; ++r) { p0[r] = __builtin_amdgcn_exp2f(fmaf(p0[r], C, mnC)); p1[r] = __builtin_amdgcn_exp2f(fmaf(p1[r], C, mnC)); }
        float ps = 0.f;
#pragma unroll
        for (int r = 0; r < 16; ++r) ps += p0[r];
#pragma unroll
        for (int r = 0; r < 16; ++r) ps += p1[r];
        { auto rr = __builtin_amdgcn_permlane32_swap(__float_as_uint(ps), __float_as_uint(ps), false, false);
          ps = __uint_as_float(rr[0]) + __uint_as_float(rr[1]); }
        l_reg = l_reg * alpha + ps;
        const unsigned pdst = pofs + (unsigned)(i & 1) * PBUF;
#define PK4(P, BASE, KS) do { unsigned a0 = cvtpk(P[BASE + 0], P[BASE + 1]), a1 = cvtpk(P[BASE + 2], P[BASE + 3]);   \
    unsigned b0_ = cvtpk(P[BASE + 4], P[BASE + 5]), b1_ = cvtpk(P[BASE + 6], P[BASE + 7]);                              \
    auto r0 = __builtin_amdgcn_permlane32_swap(a0, b0_, false, false); auto r1 = __builtin_amdgcn_permlane32_swap(a1, b1_, false, false); \
    u32x4 w = {r0[0], r1[0], r0[1], r1[1]}; *(ATY_LAS u32x4*)(uintptr_t)(pdst + (KS) * 1024u) = w; } while (0)
        PK4(p0, 0, 0); PK4(p0, 8, 1); PK4(p1, 0, 2); PK4(p1, 8, 3);
#undef PK4
        if (hi == 0) al_l[(i & 1) * 128 + r32] = alpha;
      }
      WAITV_BAR();
    }
    if (hi == 0) li_l[r32] = l_reg;
    WAITV_BAR();
    WAITV_BAR();
  } else {
    f32x16 o[8];
#pragma unroll
    for (int d = 0; d < 8; ++d) o[d] = f32x16{};
    const int vb0 = (int)(lds0 + LDS_V) + v_rd_base(lane);
    WAITV_BAR();
#pragma unroll 1
    for (int i = 0; i <= NT; ++i) {
      if (i + 1 < NT) DMA_K(i + 1, (i + 1) & 1);
      if (i < NT) DMA_V(i, i & 1);
      const int t = i - 1;
      if (t >= 0 && t <= jw) {
        const int b = t & 1;
        const float am = al_l[b * 128 + r32];
        const unsigned psrc = pofs + (unsigned)b * PBUF;
        const bf16x8 pa0 = *(const ATY_LAS bf16x8*)(uintptr_t)(psrc), pa1 = *(const ATY_LAS bf16x8*)(uintptr_t)(psrc + 1024u);
        const bf16x8 pa2 = *(const ATY_LAS bf16x8*)(uintptr_t)(psrc + 2048u), pa3 = *(const ATY_LAS bf16x8*)(uintptr_t)(psrc + 3072u);
        if (__any(am < 1.f)) {
#pragma unroll
          for (int r = 0; r < 16; ++r) { const float f = al_l[b * 128 + crow(r, hi)];
#pragma unroll
            for (int d = 0; d < 8; ++d) o[d][r] *= f; } }
        const int vb = vb0 + b * VBUF;
        pv_one<0 * 512>(o[0], vb, pa0, pa1, pa2, pa3); pv_one<1 * 512>(o[1], vb, pa0, pa1, pa2, pa3); pv_one<2 * 512>(o[2], vb, pa0, pa1, pa2, pa3); pv_one<3 * 512>(o[3], vb, pa0, pa1, pa2, pa3);
        pv_one<16384 + 0 * 512>(o[4], vb, pa0, pa1, pa2, pa3); pv_one<16384 + 1 * 512>(o[5], vb, pa0, pa1, pa2, pa3); pv_one<16384 + 2 * 512>(o[6], vb, pa0, pa1, pa2, pa3); pv_one<16384 + 3 * 512>(o[7], vb, pa0, pa1, pa2, pa3);
      }
      WAITV_BAR();
    }
    WAITV_BAR();
    float rli[16];
#pragma unroll
    for (int r = 0; r < 16; ++r) rli[r] = __builtin_amdgcn_rcpf(li_l[crow(r, hi)]);
    { ATY_LAS unsigned short* stg = (ATY_LAS unsigned short*)(lds + LDS_V + grp * 16384);
#pragma unroll
      for (int r = 0; r < 16; ++r) { const int orow = crow(r, hi);
#pragma unroll
        for (int d = 0; d < 8; ++d) { const float v = o[d][r] * rli[r]; stg[orow * 256 + d * 32 + r32] = (unsigned short)(cvtpk(v, v) & 0xffffu); } }
      asm volatile("s_waitcnt lgkmcnt(0)" ::: "memory");
      const __amdgpu_buffer_rsrc_t srdO = __builtin_amdgcn_make_buffer_rsrc((void*)Ob, 0, 0x7fffffff, 0x00020000);
#pragma unroll
      for (int i = 0; i < 16; ++i) { const int id = i * 64 + lane, row = id >> 5, ch = id & 31;
        const u32x4 v = *(const ATY_LAS u32x4*)((ATY_LAS unsigned char*)stg + row * 512 + ch * 16);
        __builtin_amdgcn_raw_buffer_store_b128(v, srdO, ((grp * QBLK + row) * LDO + ch * 8) * 2, 0, 0); } }
    asm volatile("s_waitcnt lgkmcnt(0)\n\ts_barrier" ::: "memory");
  }
#undef DMA_K
#undef DMA_V
#undef WAITV_BAR
}
#undef SBAR
}

constexpr int NWAVES = 8;
constexpr int S_ = 8192, DM = 4096, PW = 8192, PG = 2048, AW = 4096, NH = 16, DH = 128;
constexpr int P4K = 4096 + 64, P8K = 8192 + 64, P2K = 2048 + 64;
constexpr float EPS = 1e-6f;
constexpr float LAM_INIT = 0.35550906759096934f;

constexpr size_t MiB = 1u << 20;
constexpr size_t WS_CTL = 0, CTL_ZERO_BYTES = 1 * MiB;
constexpr size_t WS_ADA = 1 * MiB;
constexpr size_t WS_COS = 2 * MiB, WS_SIN = 4 * MiB;
constexpr size_t WS_W_IN = 8 * MiB;
constexpr size_t WS_W_GRP = 138 * MiB;
constexpr size_t WS_W_OUTA = 171 * MiB;
constexpr size_t WS_W_KVQG = 236 * MiB;
constexpr size_t WS_W_OUTB = 366 * MiB;
constexpr size_t WS_H1 = 399 * MiB;
constexpr size_t WS_HN = 527 * MiB;
constexpr size_t WS_UZ = 592 * MiB;
constexpr size_t WS_POOL = 848 * MiB;
constexpr size_t WS_Y = 977 * MiB;
constexpr size_t WS_KVN = 527 * MiB;
constexpr size_t WS_HNB = 592 * MiB;
constexpr size_t WS_K = 657 * MiB, WS_V = 722 * MiB, WS_Q = 787 * MiB, WS_Z = 852 * MiB;
constexpr size_t WS_OC = 917 * MiB;
constexpr size_t WS_YB = 1045 * MiB;
constexpr size_t WS_END = 1110 * MiB;
static_assert((size_t)S_ * P4K * 2 == 65 * MiB && (size_t)S_ * P8K * 2 == 129 * MiB && (size_t)4 * PG * P2K * 2 == 33 * MiB, "padded buffer sizes");
constexpr int CW_BAR = 4096;

constexpr int RING_OFF = 0;
constexpr int LDSCTL_OFF = 143360, MISC_OFF = LDSCTL_OFF + 320;
constexpr int LDS_BYTES = 147456;

#define GAS __attribute__((address_space(1)))
#define LAS __attribute__((address_space(3)))
typedef unsigned short bf16;
typedef unsigned v4u __attribute__((ext_vector_type(4)));
typedef unsigned v2u __attribute__((ext_vector_type(2)));
typedef float f32x4 __attribute__((ext_vector_type(4)));
typedef GAS unsigned gu32;
#define RLX_AGENT __ATOMIC_RELAXED, __HIP_MEMORY_SCOPE_AGENT
#define LDS_WAIT() asm volatile("s_waitcnt lgkmcnt(0)" ::: "memory")
#define VM_WAIT() asm volatile("s_waitcnt vmcnt(0)" ::: "memory")
__device__ __forceinline__ unsigned pk2(float lo, float hi) { return pg8::cvt_pk_bf16(lo, hi); }

#define XB_TMO      128
#define XB_XCNT(j)  (256  + 64 * (j))
#define XB_XSUB(j)  (1280 + 64 * (j))
#define XB_XGEN(j)  (2304 + 64 * (j))
#define XB_TOP      3328
#define XB_TOPGEN   3392
#define XCD_BAR_WORDS 3456
#define XB_SPIN_CAP (1u << 18)

__device__ __forceinline__ unsigned xb_ld(unsigned* p)              { return __hip_atomic_load(p, __ATOMIC_RELAXED, __HIP_MEMORY_SCOPE_AGENT); }
__device__ __forceinline__ unsigned xb_add(unsigned* p, unsigned v) { return __hip_atomic_fetch_add(p, v, __ATOMIC_RELAXED, __HIP_MEMORY_SCOPE_AGENT); }
__device__ __forceinline__ unsigned xb_xcc_id() { return (unsigned)__builtin_amdgcn_s_getreg((3 << 11) | 20) & 0xFu; }
#define XB_SPIN(cond, bar) do { unsigned _sp = 0; while (cond) { __builtin_amdgcn_s_sleep(1); \
    if ((++_sp & 255u) == 0u) { if (xb_ld(&(bar)[XB_TMO])) break; if (_sp > XB_SPIN_CAP) { atomicAdd(&(bar)[XB_TMO], 1u); break; } } } } while (0)

struct XcdBarrier { unsigned* bar; unsigned x; volatile LAS unsigned* st; };

__device__ __forceinline__ XcdBarrier xcd_barrier_post(unsigned* bar, volatile LAS unsigned* st) {
    XcdBarrier b; b.bar = bar; b.x = xb_xcc_id(); b.st = st;
    if (threadIdx.x == 0) (void)xb_add(&bar[XB_XCNT(b.x)], 1u);
    return b;
}
__device__ __forceinline__ void xcd_barrier_complete(unsigned* bar, unsigned x, unsigned& nloc, unsigned& nx) {
    const unsigned G = gridDim.x * gridDim.y * gridDim.z;
    unsigned sum, cnt, mine, sp = 0u;
    for (;;) {
        sum = 0u; cnt = 0u; mine = 0u;
#pragma unroll
        for (unsigned j = 0; j < 16; ++j) { const unsigned c = xb_ld(&bar[XB_XCNT(j)]); sum += c; cnt += (c > 0u) ? 1u : 0u; mine = (j == x) ? c : mine; }
        if (sum == G) break;
        __builtin_amdgcn_s_sleep(1);
        if ((++sp & 255u) == 0u) { if (xb_ld(&bar[XB_TMO])) break; if (sp > XB_SPIN_CAP) { atomicAdd(&bar[XB_TMO], 1u); break; } }
    }
    nloc = mine > 0u ? mine : 1u; nx = cnt > 0u ? cnt : 1u;
}
__device__ __forceinline__ void xcd_barrier(const XcdBarrier& b) {
    asm volatile("s_waitcnt vmcnt(0)" ::: "memory");
    __syncthreads();
    if (threadIdx.x == 0) {
        unsigned* bar = b.bar;
        __builtin_amdgcn_s_waitcnt(0);
        unsigned nloc = b.st[0], nx = b.st[1];
        if (nloc == 0u) { xcd_barrier_complete(bar, b.x, nloc, nx); b.st[0] = nloc; b.st[1] = nx; }
        const unsigned old = xb_add(&bar[XB_XSUB(b.x)], 1u);
        const unsigned gen = old / nloc;
        if (old + 1u == (gen + 1u) * nloc) {
            __builtin_amdgcn_fence(__ATOMIC_RELEASE, "agent");
            asm volatile("s_waitcnt vmcnt(0)" ::: "memory");
            const unsigned og = xb_add(&bar[XB_TOP], 1u);
            const unsigned tg = og / nx;
            if (og + 1u == (tg + 1u) * nx) xb_add(&bar[XB_TOPGEN], 1u);
            else XB_SPIN(xb_ld(&bar[XB_TOPGEN]) == tg, bar);
            __builtin_amdgcn_fence(__ATOMIC_ACQUIRE, "agent");
            xb_add(&bar[XB_XGEN(b.x)], 1u);
            asm volatile("s_waitcnt vmcnt(0)" ::: "memory");
        } else {
            XB_SPIN(xb_ld(&bar[XB_XGEN(b.x)]) == gen, bar);
            __builtin_amdgcn_fence(__ATOMIC_ACQUIRE, "agent");
            asm volatile("s_waitcnt vmcnt(0)" ::: "memory");
        }
    }
    __syncthreads();
}

struct Frame {
    LAS unsigned char* lds;
    volatile LAS unsigned* MISC;
    gu32* ctl;
    int tid, lane, wave;
    int vcu, G;
};
struct Args {
    const float* x; const float* c; const int* pos;
    const float* a_norm_g; const float* a_ada_w; const float* a_ada_b; const float* a_w_in; const float* a_w_group; const float* a_scale; const float* a_w_out;
    const float* kv_norm_g; const float* kv_ada_w; const float* kv_ada_b; const float* w_kv;
    const float* b_norm_g; const float* b_ada_w; const float* b_ada_b; const float* b_w_qg; const float* b_lam; const float* b_subln_g; const float* b_w_out; const float* final_g;
    float* out; unsigned char* ws; int ph_lo, ph_hi, li, pad;
};

__device__ __forceinline__ float wave_sum(float v) {
#pragma unroll
    for (int o = 1; o < 64; o <<= 1) v += __shfl_xor(v, o);
    return v;
}
__device__ __forceinline__ float half_sum(float v) {
#pragma unroll
    for (int o = 1; o < 32; o <<= 1) v += __shfl_xor(v, o);
    return v;
}

__device__ __forceinline__ void p0_ada(Frame& F, const Args& a) {
    LAS float* sc = (LAS float*)(F.lds + RING_OFF);
    LAS float* part = sc + 4096;
    for (int k = F.tid; k < DM; k += NWAVES * 64) { const float c = a.c[k]; sc[k] = pg8::silu_f(c); }
    __syncthreads();
    float* mall = (float*)(a.ws + WS_ADA);
    const int cg = F.lane & 31, kp = F.lane >> 5;
    for (int slab = blockIdx.x; slab < 256; slab += F.G) {
        const int j0 = slab * 128;
        const float* W; const float* bias; int N, c0;
        if (j0 < 12288) { W = a.a_ada_w; bias = a.a_ada_b; N = 12288; c0 = j0; }
        else if (j0 < 20480) { W = a.kv_ada_w; bias = a.kv_ada_b; N = 8192; c0 = j0 - 12288; }
        else { W = a.b_ada_w; bias = a.b_ada_b; N = 12288; c0 = j0 - 20480; }
        const float* wp = W + (size_t)(512 * F.wave + kp) * N + c0 + 4 * cg;
        const LAS float* sp = sc + 512 * F.wave + kp;
        f32x4 acc = (f32x4){0.f, 0.f, 0.f, 0.f};
#pragma unroll 16
        for (int i = 0; i < 256; ++i) { const f32x4 wv = *(const GAS f32x4*)(wp + (size_t)(2 * i) * N); acc += sp[2 * i] * wv; }
#pragma unroll
        for (int e = 0; e < 4; ++e) acc[e] += __shfl_xor(acc[e], 32);
        if (kp == 0) { LAS float* pp = part + F.wave * 128 + 4 * cg; pp[0] = acc[0]; pp[1] = acc[1]; pp[2] = acc[2]; pp[3] = acc[3]; }
        __syncthreads();
        if (F.tid < 128) { float s = bias[c0 + F.tid];
#pragma unroll
            for (int w = 0; w < 8; ++w) s += part[w * 128 + F.tid];
            mall[j0 + F.tid] = s; }
        __syncthreads();
    }
}
__device__ __forceinline__ void p0_rope(Frame& F, const Args& a) {
    float* cs = (float*)(a.ws + WS_COS); float* sn = (float*)(a.ws + WS_SIN);
    const int gt = blockIdx.x * (NWAVES * 64) + F.tid, NT = F.G * NWAVES * 64;
    for (int idx = gt; idx < S_ * 64; idx += NT) {
        const int row = idx >> 6, i = idx & 63;
        double inv = 1.0, b = 0.8659643233600653; int e = i;
        while (e) { if (e & 1) inv *= b; b *= b; e >>= 1; }
        const double ang = (double)a.pos[row] * inv;
        const double kq = rint(ang * 0.63661977236758134308);
        double r = fma(-kq, 1.5707963267948966, ang); r = fma(-kq, 6.123233995736766e-17, r);
        const double r2 = r * r;
        double sp = -7.6471637318198164759e-13; sp = fma(sp, r2, 1.6059043836821614599e-10); sp = fma(sp, r2, -2.5052108385441718775e-8); sp = fma(sp, r2, 2.7557319223985890653e-6);
        sp = fma(sp, r2, -1.9841269841269841270e-4); sp = fma(sp, r2, 8.3333333333333333333e-3); sp = fma(sp, r2, -1.6666666666666666667e-1); sp = fma(sp * r2, r, r);
        double cp = 4.7794773323873852974e-14; cp = fma(cp, r2, -1.1470745597729724714e-11); cp = fma(cp, r2, 2.0876756987868098979e-9); cp = fma(cp, r2, -2.7557319223985890653e-7);
        cp = fma(cp, r2, 2.4801587301587301587e-5); cp = fma(cp, r2, -1.3888888888888888889e-3); cp = fma(cp, r2, 4.1666666666666666667e-2); cp = fma(cp, r2, -0.5); cp = fma(cp, r2, 1.0);
        const int q = ((int)kq) & 3;
        const double sv = (q == 0) ? sp : (q == 1) ? cp : (q == 2) ? -sp : -cp;
        const double cv = (q == 0) ? cp : (q == 1) ? -sp : (q == 2) ? -cp : sp;
        cs[idx] = (float)cv; sn[idx] = (float)sv;
    }
}
template <bool ROPE>
__device__ __forceinline__ void p0_transpose_item(const float* W, int K, int N, bf16* WT, int ldt, int row_off, LAS float* scr, int item, int lane) {
    const int nblk = N / 64, kb = item / nblk, nb = item % nblk, k0 = 64 * kb, n0 = 64 * nb;
    f32x4 v[16];
    const float* wp = W + (size_t)(k0 + (lane >> 4)) * N + n0 + 4 * (lane & 15);
#pragma unroll
    for (int i = 0; i < 16; ++i) v[i] = *(const GAS f32x4*)(wp + (size_t)(4 * i) * N);
#pragma unroll
    for (int i = 0; i < 16; ++i) { LAS float* s = scr + (4 * i + (lane >> 4)) * 65 + 4 * (lane & 15); s[0] = v[i][0]; s[1] = v[i][1]; s[2] = v[i][2]; s[3] = v[i][3]; }
    LDS_WAIT(); asm volatile("" ::: "memory");
    const int c = lane & 7;
#pragma unroll
    for (int j = 0; j < 8; ++j) { const int n = (lane >> 3) + 8 * j; const LAS float* s = scr + (8 * c) * 65 + n;
        v4u o; o.x = pk2(s[0 * 65], s[1 * 65]); o.y = pk2(s[2 * 65], s[3 * 65]); o.z = pk2(s[4 * 65], s[5 * 65]); o.w = pk2(s[6 * 65], s[7 * 65]);
        int ng = n0 + n;
        if (ROPE && ng < 4096) { const int p = ng & 127; ng = (ng & ~127) + ((p < 64) ? 2 * p : 2 * (p - 64) + 1); }
        *(GAS v4u*)(WT + (size_t)(row_off + ng) * ldt + k0 + 8 * c) = o; }
    LDS_WAIT(); asm volatile("" ::: "memory");
}
__device__ __forceinline__ void p0_convert(Frame& F, const Args& a) {
    LAS float* scr = (LAS float*)(F.lds + RING_OFF) + F.wave * (64 * 65);
    const int gw = F.vcu * NWAVES + F.wave, NGW = F.G * NWAVES;
    constexpr int I_IN = (DM / 64) * (2 * PW / 64), I_GRP = (PG / 64) * (PG / 64), I_OA = (PW / 64) * (DM / 64), I_KV = (DM / 64) * (2 * AW / 64), I_OB = (AW / 64) * (DM / 64);
    constexpr int NITEMS = I_IN + 4 * I_GRP + I_OA + 2 * I_KV + I_OB;
    unsigned char* ws = a.ws;
    for (int it = gw; it < NITEMS; it += NGW) {
        int r = it;
        if (r < I_IN) { p0_transpose_item<false>(a.a_w_in, DM, 2 * PW, (bf16*)(ws + WS_W_IN), P4K, 0, scr, r, F.lane); continue; } r -= I_IN;
        if (r < 4 * I_GRP) { const int g = r / I_GRP; p0_transpose_item<false>(a.a_w_group + (size_t)g * PG * PG, PG, PG, (bf16*)(ws + WS_W_GRP), P2K, g * PG, scr, r % I_GRP, F.lane); continue; } r -= 4 * I_GRP;
        if (r < I_OA) { p0_transpose_item<false>(a.a_w_out, PW, DM, (bf16*)(ws + WS_W_OUTA), P8K, 0, scr, r, F.lane); continue; } r -= I_OA;
        if (r < I_KV) { p0_transpose_item<true>(a.w_kv, DM, 2 * AW, (bf16*)(ws + WS_W_KVQG), P4K, 0, scr, r, F.lane); continue; } r -= I_KV;
        if (r < I_KV) { p0_transpose_item<true>(a.b_w_qg, DM, 2 * AW, (bf16*)(ws + WS_W_KVQG), P4K, 2 * AW, scr, r, F.lane); continue; } r -= I_KV;
        p0_transpose_item<false>(a.b_w_out, AW, DM, (bf16*)(ws + WS_W_OUTB), P4K, 0, scr, r, F.lane);
    }
}
template <int NOUT>
__device__ __forceinline__ void norm_mod_rows(Frame& F, const float* xin, bf16* out0, bf16* out1, const LAS float* tab) {
    const int gw = F.vcu * NWAVES + F.wave, NGW = F.G * NWAVES;
    for (int m = gw; m < S_; m += NGW) {
        const GAS f32x4* xr = (const GAS f32x4*)(xin + (size_t)m * DM) + F.lane;
        f32x4 v[16]; float s = 0.f;
#pragma unroll
        for (int j = 0; j < 16; ++j) { v[j] = xr[64 * j]; s += (v[j].x * v[j].x + v[j].y * v[j].y) + (v[j].z * v[j].z + v[j].w * v[j].w); }
        const float rstd = 1.0f / sqrtf(wave_sum(s) * (1.f / DM) + EPS);
#pragma unroll
        for (int o = 0; o < NOUT; ++o) {
            GAS v2u* op = (GAS v2u*)((o == 0 ? out0 : out1) + (size_t)m * P4K) + F.lane;
            const LAS f32x4* gs = (const LAS f32x4*)(tab + o * 2 * DM) + F.lane; const LAS f32x4* sh = (const LAS f32x4*)(tab + o * 2 * DM + DM) + F.lane;
#pragma unroll
            for (int j = 0; j < 16; ++j) { const f32x4 g = gs[64 * j], h = sh[64 * j]; const f32x4 y = v[j] * rstd * g + h;
                v2u w; w.x = pk2(y.x, y.y); w.y = pk2(y.z, y.w); op[64 * j] = w; }
        }
    }
}
__device__ __forceinline__ void unpack8(const v4u u, float* f) {
    f[0] = pg8::bf_lo(u.x); f[1] = pg8::bf_hi(u.x); f[2] = pg8::bf_lo(u.y); f[3] = pg8::bf_hi(u.y); f[4] = pg8::bf_lo(u.z); f[5] = pg8::bf_hi(u.z); f[6] = pg8::bf_lo(u.w); f[7] = pg8::bf_hi(u.w);
}
__device__ __forceinline__ void p3_pool(Frame& F, const Args& a) {
    const bf16* U = (const bf16*)(a.ws + WS_UZ); bf16* P = (bf16*)(a.ws + WS_POOL);
    const int gt = F.vcu * (NWAVES * 64) + F.tid, NT = F.G * NWAVES * 64;
    constexpr int RB = 32, NCH = PW / 8, NITEM = (S_ / RB) * NCH;
    for (int it = gt; it < NITEM; it += NT) {
        const int ch = it % NCH, rb = it / NCH, t0 = rb * RB, w = 2 << (ch >> 8);
        const bf16* up = U + (size_t)ch * 8; bf16* pp = P + (size_t)ch * 8;
        float sum[8]; float f[8];
#pragma unroll
        for (int e = 0; e < 8; ++e) sum[e] = 0.f;
        for (int j = 1; j < w; ++j) { const int t = t0 - j; if (t >= 0) { unpack8(*(const GAS v4u*)(up + (size_t)t * (2 * PW)), f);
#pragma unroll
            for (int e = 0; e < 8; ++e) sum[e] += f[e]; } }
#pragma unroll 4
        for (int t = t0; t < t0 + RB; ++t) {
            unpack8(*(const GAS v4u*)(up + (size_t)t * (2 * PW)), f);
            const float rc = 1.0f / (float)((t + 1 < w) ? (t + 1) : w);
            float o[8];
#pragma unroll
            for (int e = 0; e < 8; ++e) { sum[e] += f[e]; o[e] = sum[e] * rc - f[e]; }
            v4u ov; ov.x = pk2(o[0], o[1]); ov.y = pk2(o[2], o[3]); ov.z = pk2(o[4], o[5]); ov.w = pk2(o[6], o[7]);
            *(GAS v4u*)(pp + (size_t)t * P8K) = ov;
            const int tl = t - w + 1;
            if (tl >= 0) { unpack8(*(const GAS v4u*)(up + (size_t)tl * (2 * PW)), f);
#pragma unroll
                for (int e = 0; e < 8; ++e) sum[e] -= f[e]; }
        }
    }
}
__device__ __forceinline__ void p9_combine(Frame& F, const Args& a) {
    float d1 = 0.f, d2 = 0.f;
    for (int i = F.lane; i < DH; i += 64) { d1 += a.b_lam[i] * a.b_lam[DH + i]; d2 += a.b_lam[2 * DH + i] * a.b_lam[3 * DH + i]; }
    d1 = wave_sum(d1); d2 = wave_sum(d2);
    const float lam = expf(d1) - expf(d2) + LAM_INIT;
    const bf16* OC = (const bf16*)(a.ws + WS_OC); const bf16* Z = (const bf16*)(a.ws + WS_Z); bf16* YB = (bf16*)(a.ws + WS_YB);
    const int gw = F.vcu * NWAVES + F.wave, NGW = F.G * NWAVES;
    float g8[8];
    { const float* gp = a.b_subln_g + 8 * (F.lane & 31);
#pragma unroll
      for (int e = 0; e < 8; ++e) g8[e] = gp[e] * (1.0f - LAM_INIT); }
    for (int m = gw; m < S_; m += NGW) {
        const GAS v4u* o0p = (const GAS v4u*)(OC + (size_t)m * (2 * AW)) + F.lane; const GAS v4u* o1p = (const GAS v4u*)(OC + (size_t)m * (2 * AW) + AW) + F.lane;
        const GAS v4u* zp = (const GAS v4u*)(Z + (size_t)m * P4K) + F.lane; GAS v4u* yp = (GAS v4u*)(YB + (size_t)m * P4K) + F.lane;
#pragma unroll 2
        for (int j = 0; j < 8; ++j) {
            float f0[8], f1[8], fz[8], o[8];
            unpack8(o0p[64 * j], f0); unpack8(o1p[64 * j], f1); unpack8(zp[64 * j], fz);
            float ss = 0.f;
#pragma unroll
            for (int e = 0; e < 8; ++e) { o[e] = f0[e] - lam * f1[e]; ss += o[e] * o[e]; }
            const float rstd = 1.0f / sqrtf(half_sum(ss) * (1.f / 256.f) + EPS);
#pragma unroll
            for (int e = 0; e < 8; ++e) o[e] = o[e] * rstd * g8[e] * pg8::silu_f(fz[e]);
            v4u ov; ov.x = pk2(o[0], o[1]); ov.y = pk2(o[2], o[3]); ov.z = pk2(o[4], o[5]); ov.w = pk2(o[6], o[7]);
            yp[64 * j] = ov;
        }
    }
}
__device__ __forceinline__ void p11_final(Frame& F, const Args& a) {
    const int gw = F.vcu * NWAVES + F.wave, NGW = F.G * NWAVES;
    for (int m = gw; m < S_; m += NGW) {
        GAS f32x4* xr = (GAS f32x4*)(a.out + (size_t)m * DM) + F.lane; const GAS f32x4* gp = (const GAS f32x4*)a.final_g + F.lane;
        f32x4 v[16]; float s = 0.f;
#pragma unroll
        for (int j = 0; j < 16; ++j) { v[j] = xr[64 * j]; s += (v[j].x * v[j].x + v[j].y * v[j].y) + (v[j].z * v[j].z + v[j].w * v[j].w); }
        const float rstd = 1.0f / sqrtf(wave_sum(s) * (1.f / DM) + EPS);
#pragma unroll
        for (int j = 0; j < 16; ++j) xr[64 * j] = v[j] * rstd * gp[64 * j];
    }
}

__global__ void __launch_bounds__(NWAVES * 64, 2) yoco_fwd(Args args) {
    extern __shared__ __attribute__((aligned(16))) unsigned char lds[];
    Frame F;
    F.lds = (LAS unsigned char*)lds;
    F.MISC = (volatile LAS unsigned*)(F.lds + MISC_OFF);
    F.tid = threadIdx.x; F.lane = F.tid & 63; F.wave = __builtin_amdgcn_readfirstlane(F.tid >> 6);
    F.G = gridDim.x; { const int bx = blockIdx.x; F.vcu = (F.G % 8 == 0) ? (bx % 8) * (F.G / 8) + bx / 8 : bx; }
    unsigned char* ws = args.ws;
    F.ctl = (gu32*)(ws + WS_CTL);
    for (int u = F.tid; u < (LDS_BYTES - LDSCTL_OFF) / 4; u += NWAVES * 64) ((LAS unsigned*)(F.lds + LDSCTL_OFF))[u] = 0u;
    __syncthreads();
    XcdBarrier bar; bar.bar = (unsigned*)(F.ctl + CW_BAR); bar.x = 0; bar.st = nullptr;
    if (N_LAUNCHES == 1) bar = xcd_barrier_post((unsigned*)(F.ctl + CW_BAR), F.MISC + 8);
#define GRID_BAR() do { if (N_LAUNCHES == 1) xcd_barrier(bar); } while (0)
    const int lo = args.ph_lo, hi = args.ph_hi;
#define IN(k) (lo <= (k) && (k) < hi)
#define BOTH(k) (IN(k) && IN((k) + 1))
    const float* mall = (const float*)(ws + WS_ADA);

    if (IN(0)) { p0_ada(F, args); p0_rope(F, args); p0_convert(F, args);
        if (PROBE_DUP == 0) { __syncthreads(); p0_ada(F, args); p0_rope(F, args); p0_convert(F, args); }
        if (BOTH(0)) GRID_BAR(); }

    if (IN(1)) {
        LAS float* tab = (LAS float*)(F.lds + RING_OFF);
        for (int c = F.tid; c < DM; c += NWAVES * 64) { tab[c] = args.a_norm_g[c] * (1.0f + mall[DM + c]); tab[DM + c] = mall[c]; }
        __syncthreads();
        norm_mod_rows<1>(F, args.x, (bf16*)(ws + WS_HN), nullptr, tab);
        if (BOTH(1)) GRID_BAR();
    }
    if (IN(2)) {
        pg8::Gemm g{(const pg8::bf16_t*)(ws + WS_HN), (const pg8::bf16_t*)(ws + WS_W_IN), S_, 2 * PW, DM, P4K, P4K, 1 << 20, 0};
        pg8::StaticOrder S; S.init(S_, 2 * PW, F.G, (int)blockIdx.x);
        pg8::EpiBf16 E{(pg8::bf16_t*)(ws + WS_UZ), 2 * PW};
        pg8::gemm_phase<pg8::EpiBf16, pg8::StaticOrder, true, true>(F.lds + RING_OFF, g, S, E);
        if (PROBE_DUP == 2) { __syncthreads(); pg8::gemm_phase<pg8::EpiBf16, pg8::StaticOrder, true, true>(F.lds + RING_OFF, g, S, E); }
        if (PROBE_DUP == 102) { __syncthreads(); pg8::EpiNull EN; pg8::gemm_phase<pg8::EpiNull, pg8::StaticOrder, true, true>(F.lds + RING_OFF, g, S, EN); }
        if (BOTH(2)) GRID_BAR();
    }
    if (IN(3)) { p3_pool(F, args); if (BOTH(3)) GRID_BAR(); }
    if (IN(4)) {
        pg8::Gemm g{(const pg8::bf16_t*)(ws + WS_POOL), (const pg8::bf16_t*)(ws + WS_W_GRP), S_, PW, PG, P8K, P2K, 8, (long)PG * 2};
        pg8::StaticOrder S; S.init(S_, PW, F.G, (int)blockIdx.x);
        pg8::EpiPoolY E{(pg8::bf16_t*)(ws + WS_Y), P8K, args.a_scale, (const pg8::bf16_t*)(ws + WS_UZ) + PW, 2 * PW};
        pg8::gemm_phase<pg8::EpiPoolY, pg8::StaticOrder, true, true>(F.lds + RING_OFF, g, S, E);
        if (BOTH(4)) GRID_BAR();
    }
    if (IN(5)) {
        pg8::Gemm g{(const pg8::bf16_t*)(ws + WS_Y), (const pg8::bf16_t*)(ws + WS_W_OUTA), S_, DM, PW, P8K, P8K, 1 << 20, 0};
        pg8::StaticOrder S; S.init(S_, DM, F.G, (int)blockIdx.x);
        pg8::EpiResid E{args.x, (float*)(ws + WS_H1), DM, mall + 2 * DM};
        pg8::gemm_phase<pg8::EpiResid, pg8::StaticOrder, true, true>(F.lds + RING_OFF, g, S, E);
        if (BOTH(5)) GRID_BAR();
    }
    if (IN(6)) {
        LAS float* tab = (LAS float*)(F.lds + RING_OFF);
        const float* mkv = mall + 12288; const float* mb = mall + 20480;
        for (int c = F.tid; c < DM; c += NWAVES * 64) {
            tab[c] = args.kv_norm_g[c] * (1.0f + mkv[DM + c]); tab[DM + c] = mkv[c];
            tab[2 * DM + c] = args.b_norm_g[c] * (1.0f + mb[DM + c]); tab[3 * DM + c] = mb[c]; }
        __syncthreads();
        norm_mod_rows<2>(F, (const float*)(ws + WS_H1), (bf16*)(ws + WS_KVN), (bf16*)(ws + WS_HNB), tab);
        if (BOTH(6)) GRID_BAR();
    }
    if (IN(7)) {
        pg8::Gemm g{(const pg8::bf16_t*)(ws + WS_KVN), (const pg8::bf16_t*)(ws + WS_W_KVQG), S_, 4 * AW, DM, P4K, P4K, 32, (long)(WS_HNB - WS_KVN)};
        pg8::StaticOrder S; S.init(S_, 4 * AW, F.G, (int)blockIdx.x);
        pg8::EpiKVQZ E{(pg8::bf16_t*)(ws + WS_K), (size_t)(WS_V - WS_K) / 2, P4K, S_, (const float*)(ws + WS_COS), (const float*)(ws + WS_SIN)};
        pg8::gemm_phase<pg8::EpiKVQZ, pg8::StaticOrder, true, true>(F.lds + RING_OFF, g, S, E);
        if (BOTH(7)) GRID_BAR();
    }
    if (IN(8)) {
        static_assert(atty::LDS_END <= LDSCTL_OFF, "attention LDS");
        const atty::bf16* Q = (const atty::bf16*)(ws + WS_Q); const atty::bf16* Kt = (const atty::bf16*)(ws + WS_K); const atty::bf16* V = (const atty::bf16*)(ws + WS_V); atty::bf16* OC = (atty::bf16*)(ws + WS_OC);
        const int npair = 32 * 32;
#pragma unroll 1
        for (int rep_ = 0; rep_ < ((PROBE_DUP == 8) ? 2 : 1); ++rep_)
#pragma unroll 1
        for (int pi = F.vcu; pi < npair; pi += F.G) {
            const int hh = pi >> 5, p = pi & 31, h = hh >> 1, c = hh & 1;
#pragma unroll 1
            for (int s = 0; s < 2; ++s) {
                const int qb = s ? p : 63 - p, q0 = qb * atty::UROWS;
                atty::attn_unit(Q + ((size_t)hh * S_ + q0) * DH, Kt + (size_t)hh * S_ * DH, V + (size_t)h * S_ * 256,
                                OC + (size_t)q0 * (2 * AW) + c * AW + h * 256, 2 * qb + 2, 2 * qb + ((F.wave & 3) >> 1), F.lds + RING_OFF);
            }
        }
        if (BOTH(8)) GRID_BAR();
    }
    if (IN(9)) { p9_combine(F, args); if (BOTH(9)) GRID_BAR(); }
    if (IN(10)) {
        pg8::Gemm g{(const pg8::bf16_t*)(ws + WS_YB), (const pg8::bf16_t*)(ws + WS_W_OUTB), S_, DM, AW, P4K, P4K, 1 << 20, 0};
        pg8::StaticOrder S; S.init(S_, DM, F.G, (int)blockIdx.x);
        pg8::EpiResid E{(const float*)(ws + WS_H1), args.out, DM, mall + 20480 + 2 * DM};
        pg8::gemm_phase<pg8::EpiResid, pg8::StaticOrder, true, true>(F.lds + RING_OFF, g, S, E);
        if (BOTH(10)) GRID_BAR();
    }
    if (IN(11)) { p11_final(F, args); }
#undef IN
#undef BOTH
#undef GRID_BAR
}

extern "C" void kernel_launch(void* const* d_in, const int* in_sizes, int n_in, void* d_out, int out_size, void* d_ws, size_t ws_size, hipStream_t stream) {
    static int grid = 0;
    if (grid == 0) {
        if (n_in != 22 || in_sizes[0] != S_ * DM || out_size != S_ * DM || ws_size < WS_END) {
            fprintf(stderr, "kernel_launch: shape mismatch: n_in %d in0 %d out %d ws %zu (need %zu)\n", n_in, n_in > 0 ? in_sizes[0] : -1, out_size, ws_size, (size_t)WS_END); grid = -1; return; }
        int dev = 0, cus = 0, per_cu = 0;
        if (hipGetDevice(&dev) != hipSuccess || hipDeviceGetAttribute(&cus, hipDeviceAttributeMultiprocessorCount, dev) != hipSuccess) { fprintf(stderr, "kernel_launch: device query failed\n"); grid = -1; return; }
        if (hipFuncSetAttribute((const void*)yoco_fwd, hipFuncAttributeMaxDynamicSharedMemorySize, LDS_BYTES) != hipSuccess) { fprintf(stderr, "kernel_launch: hipFuncSetAttribute failed\n"); grid = -1; return; }
        if (hipOccupancyMaxActiveBlocksPerMultiprocessor(&per_cu, (const void*)yoco_fwd, NWAVES * 64, LDS_BYTES) != hipSuccess || per_cu < 1)
            fprintf(stderr, "kernel_launch: occupancy query reports %d workgroups per CU\n", per_cu);
        (void)hipGetLastError();
        grid = cus;
    }
    if (grid < 0) return;
    if (hipMemsetAsync((char*)d_ws + WS_CTL, 0, CTL_ZERO_BYTES, stream) != hipSuccess) { fprintf(stderr, "kernel_launch: memset failed\n"); return; }
    Args a{};
    a.x = (const float*)d_in[0]; a.c = (const float*)d_in[1]; a.pos = (const int*)d_in[2];
    a.a_norm_g = (const float*)d_in[3]; a.a_ada_w = (const float*)d_in[4]; a.a_ada_b = (const float*)d_in[5]; a.a_w_in = (const float*)d_in[6]; a.a_w_group = (const float*)d_in[7];
    a.a_scale = (const float*)d_in[8]; a.a_w_out = (const float*)d_in[9];
    a.kv_norm_g = (const float*)d_in[10]; a.kv_ada_w = (const float*)d_in[11]; a.kv_ada_b = (const float*)d_in[12]; a.w_kv = (const float*)d_in[13];
    a.b_norm_g = (const float*)d_in[14]; a.b_ada_w = (const float*)d_in[15]; a.b_ada_b = (const float*)d_in[16]; a.b_w_qg = (const float*)d_in[17]; a.b_lam = (const float*)d_in[18];
    a.b_subln_g = (const float*)d_in[19]; a.b_w_out = (const float*)d_in[20]; a.final_g = (const float*)d_in[21];
    a.out = (float*)d_out; a.ws = (unsigned char*)d_ws;
    for (int li = 0; li < N_LAUNCHES; ++li) {
        a.ph_lo = (N_LAUNCHES == 1) ? 0 : li; a.ph_hi = (N_LAUNCHES == 1) ? N_PHASES : li + 1; a.li = li; a.pad = 0;
        hipLaunchKernelGGL(yoco_fwd, dim3(grid), dim3(NWAVES * 64), LDS_BYTES, stream, a);
        const hipError_t le = hipPeekAtLastError();
        if (le != hipSuccess) { fprintf(stderr, "kernel_launch: launch %d failed: %s\n", li, hipGetErrorName(le)); break; }
    }
}
```

```cpp
#include <hip/hip_runtime.h>
#include <hip/hip_bf16.h>
#include <cstdio>
#include <cstdint>
#include <cmath>

#ifndef MK_N_LAUNCHES
#define MK_N_LAUNCHES 1
#endif
constexpr int N_PHASES = 12;
#ifndef PROBE_DUP
#define PROBE_DUP -1
#endif
constexpr int N_LAUNCHES = MK_N_LAUNCHES;

namespace pg8 {
#define PG8_LAS __attribute__((address_space(3)))
typedef unsigned short bf16_t;
typedef short bf16x8 __attribute__((ext_vector_type(8)));
typedef float f32x4 __attribute__((ext_vector_type(4)));
typedef float f32x2 __attribute__((ext_vector_type(2)));
typedef unsigned u32x4 __attribute__((ext_vector_type(4)));
constexpr int BM = 256, BK = 64, HALF = 128, HTB = HALF * BK * 2, STAGE_BYTES = 8 * HTB, NXCD = 8, WGM = 8;

__host__ __device__ __forceinline__ int lds_byte(int r, int c) { const int st = (r >> 4) * 2 + (c >> 5), rr = r & 15, cc = c & 31, ob = rr * 64 + cc * 2; return st * 1024 + (ob ^ (((ob >> 9) & 1) << 5)); }
__host__ __device__ __forceinline__ void stage_rc(int b, int& R, int& C) { const int st = b / 1024, sb = b % 1024, swz = sb ^ (((sb >> 9) & 1) << 5); R = (st >> 1) * 16 + swz / 64; C = (st & 1) * 32 + (swz % 64) / 2; }
__host__ __device__ __forceinline__ int perm32(int rho) { const int n = rho >> 4, i = rho & 15; return 8 * (i >> 2) + 4 * n + (i & 3); }

struct Unit { int pm, pn; };
struct Gemm { const bf16_t* A; const bf16_t* Bt; int M, N, K, lda, ldb, adiv; long astride; int bdiv; long bstride; };

struct StaticOrder {
    int nM, nN, nwg, G, c;
    __host__ __device__ void init(int M, int N, int G_, int c_) { nM = M / BM; nN = N / BM; nwg = nM * nN; G = G_; c = c_; }
    __host__ __device__ bool next(int i, Unit& u) const {
        const long L = (long)i * G + c; if (L >= nwg) return false;
        int wgid = (int)L; { const int q = nwg / NXCD, r = nwg % NXCD, xcd = wgid % NXCD, off = wgid / NXCD; wgid = (xcd < r ? xcd * (q + 1) : r * (q + 1) + (xcd - r) * q) + off; }
        const int nig = WGM * nN, gid = wgid / nig, fm = gid * WGM, gsz = (nM - fm) < WGM ? (nM - fm) : WGM;
        u.pm = fm + ((wgid % nig) % gsz); u.pn = (wgid % nig) / gsz; return true;
    }
    __device__ __forceinline__ void a_ready(const Unit&) const {}
    __device__ __forceinline__ void done(const Unit&) const {}
};

struct SameTileOrder : StaticOrder {
    __host__ __device__ bool next(int i, Unit& u) const { if (!StaticOrder::next(i, u)) return false; u.pm = 0; u.pn = 0; return true; }
};
__device__ __forceinline__ unsigned cvt_pk_bf16(float lo, float hi) { unsigned r; asm volatile("v_cvt_pk_bf16_f32 %0, %1, %2" : "=v"(r) : "v"(lo), "v"(hi)); return r; }
__device__ __forceinline__ float bf_lo(unsigned u) { return __uint_as_float(u << 16); }
__device__ __forceinline__ float bf_hi(unsigned u) { return __uint_as_float(u & 0xffff0000u); }
__device__ __forceinline__ float silu_f(float z) { return z * __builtin_amdgcn_rcpf(1.0f + __builtin_amdgcn_exp2f(-1.4426950408889634f * z)); }


struct EpiBf16 {
    static constexpr bool PERM = true;
    bf16_t* O; int ldc;
    __device__ __forceinline__ void operator()(const f32x4 (&acc)[2][2][4][2], const Unit& u, int wr, int wc, int fr, int fq) const {
        const int row0 = u.pm * BM + wr * 64 + fr, col0 = u.pn * BM + wc * 32 + 8 * fq;
#pragma unroll
        for (int ai = 0; ai < 2; ++ai)
#pragma unroll
            for (int m = 0; m < 4; ++m) { bf16_t* rowp = O + (size_t)(row0 + ai * HALF + m * 16) * ldc + col0;
#pragma unroll
                for (int bj = 0; bj < 2; ++bj) { const f32x4 v0 = acc[ai][bj][m][0], v1 = acc[ai][bj][m][1];
                    u32x4 w; w.x = cvt_pk_bf16(v0[0], v0[1]); w.y = cvt_pk_bf16(v0[2], v0[3]); w.z = cvt_pk_bf16(v1[0], v1[1]); w.w = cvt_pk_bf16(v1[2], v1[3]);
                    *(u32x4*)(rowp + bj * HALF) = w; } }
    }
};
struct EpiNull {
    static constexpr bool PERM = true;
    __device__ __forceinline__ void operator()(const f32x4 (&acc)[2][2][4][2], const Unit&, int, int, int, int) const {
#pragma unroll
        for (int ai = 0; ai < 2; ++ai)
#pragma unroll
            for (int bj = 0; bj < 2; ++bj)
#pragma unroll
                for (int m = 0; m < 4; ++m)
#pragma unroll
                    for (int n = 0; n < 2; ++n) { f32x4 v = acc[ai][bj][m][n]; asm volatile("" :: "v"(v)); }
    }
};
struct EpiPoolY {
    static constexpr bool PERM = true;
    bf16_t* O; int ldc; const float* cscale; const bf16_t* Z; int ldz;
    __device__ __forceinline__ void operator()(const f32x4 (&acc)[2][2][4][2], const Unit& u, int wr, int wc, int fr, int fq) const {
        const int row0 = u.pm * BM + wr * 64 + fr, col0 = u.pn * BM + wc * 32 + 8 * fq;
        f32x4 sv[2][2];
#pragma unroll
        for (int bj = 0; bj < 2; ++bj)
#pragma unroll
            for (int n = 0; n < 2; ++n) sv[bj][n] = *(const f32x4*)(cscale + col0 + bj * HALF + 4 * n);
#pragma unroll
        for (int ai = 0; ai < 2; ++ai)
#pragma unroll
            for (int m = 0; m < 4; ++m) { const size_t r = (size_t)(row0 + ai * HALF + m * 16); bf16_t* rowp = O + r * ldc + col0; const bf16_t* zp = Z + r * ldz + col0;
#pragma unroll
                for (int bj = 0; bj < 2; ++bj) { const u32x4 zz = *(const u32x4*)(zp + bj * HALF);
                    const f32x4 v0 = acc[ai][bj][m][0] * sv[bj][0], v1 = acc[ai][bj][m][1] * sv[bj][1];
                    u32x4 w;
                    w.x = cvt_pk_bf16(v0[0] * silu_f(bf_lo(zz.x)), v0[1] * silu_f(bf_hi(zz.x)));
                    w.y = cvt_pk_bf16(v0[2] * silu_f(bf_lo(zz.y)), v0[3] * silu_f(bf_hi(zz.y)));
                    w.z = cvt_pk_bf16(v1[0] * silu_f(bf_lo(zz.z)), v1[1] * silu_f(bf_hi(zz.z)));
                    w.w = cvt_pk_bf16(v1[2] * silu_f(bf_lo(zz.w)), v1[3] * silu_f(bf_hi(zz.w)));
                    *(u32x4*)(rowp + bj * HALF) = w; } }
    }
};
struct EpiResid {
    static constexpr bool PERM = false;
    const float* base; float* out; int ldc; const float* gate;
    __device__ __forceinline__ void operator()(const f32x4 (&acc)[2][2][4][2], const Unit& u, int wr, int wc, int fr, int fq) const {
        const int row0 = u.pm * BM + wr * 64 + fr, col0 = u.pn * BM + wc * 32 + 4 * fq;
        f32x4 gv[2][2];
#pragma unroll
        for (int bj = 0; bj < 2; ++bj)
#pragma unroll
            for (int n = 0; n < 2; ++n) gv[bj][n] = *(const f32x4*)(gate + col0 + bj * HALF + n * 16);
#pragma unroll
        for (int ai = 0; ai < 2; ++ai)
#pragma unroll
            for (int m = 0; m < 4; ++m) { const size_t off = (size_t)(row0 + ai * HALF + m * 16) * ldc + col0;
#pragma unroll
                for (int bj = 0; bj < 2; ++bj)
#pragma unroll
                    for (int n = 0; n < 2; ++n) { const f32x4 b = *(const f32x4*)(base + off + bj * HALF + n * 16);
                        *(f32x4*)(out + off + bj * HALF + n * 16) = b + gv[bj][n] * acc[ai][bj][m][n]; } }
    }
};
struct EpiKVQZ {
    static constexpr bool PERM = true;
    bf16_t* O; size_t tstride; int ldz; int S; const float* cs; const float* sn; float qscale;
    __device__ __forceinline__ void operator()(const f32x4 (&acc)[2][2][4][2], const Unit& u, int wr, int wc, int fr, int fq) const {
        const int t = u.pn >> 4, pt = u.pn & 15; const bool rot = (t == 0) || (t == 2);
        const int row0 = u.pm * BM + wr * 64 + fr, cw = wc * 32 + 8 * fq, i0 = wc * 16 + 4 * fq;
        bf16_t* base = O + (size_t)t * tstride;
#pragma unroll
        for (int ai = 0; ai < 2; ++ai)
#pragma unroll
            for (int m = 0; m < 4; ++m) { const int row = row0 + ai * HALF + m * 16;
                f32x4 c4 = (f32x4){1.f, 1.f, 1.f, 1.f}, s4 = (f32x4){0.f, 0.f, 0.f, 0.f};
                if (rot) { c4 = *(const f32x4*)(cs + (size_t)row * 64 + i0); s4 = *(const f32x4*)(sn + (size_t)row * 64 + i0); }
                if (t == 2) { c4 = c4 * qscale; s4 = s4 * qscale; }
#pragma unroll
                for (int bj = 0; bj < 2; ++bj) { const f32x4 v0 = acc[ai][bj][m][0], v1 = acc[ai][bj][m][1];
                    u32x4 w;
                    w.x = cvt_pk_bf16(v0[0] * c4[0] - v0[1] * s4[0], v0[1] * c4[0] + v0[0] * s4[0]);
                    w.y = cvt_pk_bf16(v0[2] * c4[1] - v0[3] * s4[1], v0[3] * c4[1] + v0[2] * s4[1]);
                    w.z = cvt_pk_bf16(v1[0] * c4[2] - v1[1] * s4[2], v1[1] * c4[2] + v1[0] * s4[2]);
                    w.w = cvt_pk_bf16(v1[2] * c4[3] - v1[3] * s4[3], v1[3] * c4[3] + v1[2] * s4[3]);
                    bf16_t* dst;
                    if (t == 3) dst = base + (size_t)row * ldz + pt * BM + bj * HALF + cw;
                    else if (t == 1) dst = base + ((size_t)pt * S + row) * 256 + bj * HALF + cw;
                    else dst = base + ((size_t)(pt * 2 + bj) * S + row) * 128 + cw;
                    *(u32x4*)dst = w; } }
    }
};

template <class Epi, class Sched, bool ALIGN_EPI = false, bool SP2 = false>
__device__ __forceinline__ void gemm_phase(PG8_LAS unsigned char* lds, const Gemm g, const Sched& S, const Epi& E) {
    const int tid = threadIdx.x, wid = __builtin_amdgcn_readfirstlane(tid >> 6), lane = tid & 63, wr = wid >> 2, wc = wid & 3, fr = lane & 15, fq = lane >> 4;
    const int K = g.K, nt = K / BK;
    unsigned voffA[2], voffB[2];
#pragma unroll
    for (int i = 0; i < 2; ++i) { int R, C; stage_rc(tid * 16 + i * 8192, R, C); const int Rb = Epi::PERM ? ((R & ~31) + perm32(R & 31)) : R;
        voffA[i] = (unsigned)(R * g.lda + C) * 2u; voffB[i] = (unsigned)(Rb * g.ldb + C) * 2u; }
    const size_t kstep = (size_t)(BK * 2);
    const size_t hstepA = (size_t)HALF * g.lda * 2, hstepB = (size_t)HALF * g.ldb * 2;
    const unsigned ldsw = (unsigned)wid * 1024u;
    const int aoff = lds_byte(wr * 64 + fr, fq * 8), boff = lds_byte(wc * 32 + fr, fq * 8);
#define PG8_UA(u) ((const char*)g.A + (size_t)(u).pm * 2 * hstepA + (size_t)((u).pn / g.adiv) * (size_t)g.astride)
#define PG8_UB(u) ((const char*)g.Bt + (size_t)(u).pn * 2 * hstepB + (size_t)((u).pm / g.bdiv) * (size_t)g.bstride)
#define PG8_SA(b, h) (((b) * 2 + (h)) * HTB)
#define PG8_SB(b, h) ((4 + (b) * 2 + (h)) * HTB)
#define PG8_STAGE(bufoff, gbase, voff) do { _Pragma("unroll") for (int _i = 0; _i < 2; ++_i) \
        __builtin_amdgcn_global_load_lds((const unsigned*)((const char*)(gbase) + (voff)[_i]), (PG8_LAS unsigned*)(lds + (bufoff) + ldsw + _i * 8192), 16, 0, 0); } while (0)
#define PG8_LDA(dst, b, h) do { _Pragma("unroll") for (int m = 0; m < 4; ++m) _Pragma("unroll") for (int k = 0; k < 2; ++k) dst[m][k] = *(const PG8_LAS bf16x8*)(lds + PG8_SA(b, h) + aoff + m * 2048 + k * 1024); } while (0)
#define PG8_LDB(dst, b, h) do { _Pragma("unroll") for (int n = 0; n < 2; ++n) _Pragma("unroll") for (int k = 0; k < 2; ++k) dst[n][k] = *(const PG8_LAS bf16x8*)(lds + PG8_SB(b, h) + boff + n * 2048 + k * 1024); } while (0)
#define PG8_MMA(ai, bj, At, Bt) do { __builtin_amdgcn_s_setprio(1); _Pragma("unroll") for (int m = 0; m < 4; ++m) _Pragma("unroll") for (int n = 0; n < 2; ++n) _Pragma("unroll") for (int k = 0; k < 2; ++k) \
        acc[ai][bj][m][n] = __builtin_amdgcn_mfma_f32_16x16x32_bf16(Bt[n][k], At[m][k], acc[ai][bj][m][n], 0, 0, 0); __builtin_amdgcn_s_setprio(0); } while (0)
#define PG8_WAIT_V(n) asm volatile("s_waitcnt vmcnt(" #n ")" ::: "memory")
#define PG8_WAIT_L(n) asm volatile("s_waitcnt lgkmcnt(" #n ")" ::: "memory")
#define PG8_BAR __builtin_amdgcn_s_barrier()
#define PG8_SCHED __builtin_amdgcn_sched_barrier(0)
    Unit cur, nxt; int ui = 0;
    if (!S.next(0, cur)) return;
    f32x4 acc[2][2][4][2];
#pragma unroll
    for (int a = 0; a < 2; ++a)
#pragma unroll
        for (int b = 0; b < 2; ++b)
#pragma unroll
            for (int m = 0; m < 4; ++m)
#pragma unroll
                for (int n = 0; n < 2; ++n) acc[a][b][m][n] = (f32x4){0.f, 0.f, 0.f, 0.f};
    bf16x8 At[4][2], B0[2][2], B1[2][2];
    const char* cA = PG8_UA(cur); const char* cB = PG8_UB(cur);
    S.a_ready(cur);
    if constexpr (SP2) {
        PG8_STAGE(PG8_SB(0, 0), cB, voffB); PG8_STAGE(PG8_SB(0, 1), cB + hstepB, voffB); PG8_STAGE(PG8_SA(0, 0), cA, voffA); PG8_STAGE(PG8_SA(0, 1), cA + hstepA, voffA);
        if (wr == 1) PG8_BAR;
        PG8_WAIT_V(2); PG8_BAR;
        PG8_STAGE(PG8_SB(1, 0), cB + kstep, voffB); PG8_STAGE(PG8_SA(1, 0), cA + kstep, voffA); PG8_STAGE(PG8_SB(1, 1), cB + hstepB + kstep, voffB);
        PG8_WAIT_V(6); PG8_BAR;
    } else {
        PG8_STAGE(PG8_SB(0, 0), cB, voffB); PG8_STAGE(PG8_SA(0, 0), cA, voffA); PG8_STAGE(PG8_SB(0, 1), cB + hstepB, voffB); PG8_STAGE(PG8_SA(0, 1), cA + hstepA, voffA);
        if (wr == 1) PG8_BAR;
        PG8_WAIT_V(4); PG8_BAR;
        PG8_STAGE(PG8_SB(1, 0), cB + kstep, voffB); PG8_STAGE(PG8_SA(1, 0), cA + kstep, voffA); PG8_STAGE(PG8_SB(1, 1), cB + hstepB + kstep, voffB);
        PG8_WAIT_V(6); PG8_BAR;
    }
    for (;;) {
        const bool has_next = S.next(ui + 1, nxt);
        const char* nA = has_next ? PG8_UA(nxt) : cA; const char* nB = has_next ? PG8_UB(nxt) : cB;
        for (int t = 0; t < nt; t += 2) {
            const bool last = (t == nt - 2);
            const char* a1 = cA + (size_t)(t + 1) * kstep;
            const char* a2 = last ? nA : cA + (size_t)(t + 2) * kstep; const char* b2 = last ? nB : cB + (size_t)(t + 2) * kstep;
            const char* a3 = a2 + kstep; const char* b3 = b2 + kstep;
            if (last && has_next) S.a_ready(nxt);
            if constexpr (SP2) {
            PG8_LDB(B0, 0, 0); PG8_LDB(B1, 0, 1); PG8_SCHED; PG8_LDA(At, 0, 0); PG8_STAGE(PG8_SA(1, 1), a1 + hstepA, voffA);
            PG8_WAIT_V(8); PG8_WAIT_L(0); PG8_BAR; PG8_MMA(0, 0, At, B0); PG8_MMA(0, 1, At, B1); PG8_BAR; PG8_SCHED;
            PG8_LDA(At, 0, 1); PG8_STAGE(PG8_SB(0, 0), b2, voffB); PG8_STAGE(PG8_SB(0, 1), b2 + hstepB, voffB); PG8_STAGE(PG8_SA(0, 0), a2, voffA);
            PG8_WAIT_V(8); PG8_WAIT_L(0); PG8_BAR; PG8_MMA(1, 0, At, B0); PG8_MMA(1, 1, At, B1); PG8_BAR; PG8_SCHED;
            PG8_LDB(B0, 1, 0); PG8_LDB(B1, 1, 1); PG8_SCHED; PG8_LDA(At, 1, 0); PG8_STAGE(PG8_SA(0, 1), a2 + hstepA, voffA);
            PG8_WAIT_V(8); PG8_WAIT_L(0); PG8_BAR; PG8_MMA(0, 0, At, B0); PG8_MMA(0, 1, At, B1); PG8_BAR; PG8_SCHED;
            PG8_LDA(At, 1, 1); PG8_STAGE(PG8_SB(1, 0), b3, voffB); PG8_STAGE(PG8_SB(1, 1), b3 + hstepB, voffB); PG8_STAGE(PG8_SA(1, 0), a3, voffA);
            PG8_WAIT_V(8); PG8_WAIT_L(0); PG8_BAR; PG8_MMA(1, 0, At, B0); PG8_MMA(1, 1, At, B1); PG8_BAR; PG8_SCHED;
            } else {
            PG8_LDB(B0, 0, 0); PG8_SCHED; PG8_LDA(At, 0, 0); PG8_STAGE(PG8_SA(1, 1), a1 + hstepA, voffA);
            PG8_WAIT_L(8); PG8_BAR; PG8_WAIT_L(0); PG8_MMA(0, 0, At, B0); PG8_BAR; PG8_SCHED;
            PG8_LDB(B1, 0, 1); PG8_STAGE(PG8_SB(0, 0), b2, voffB);
            PG8_BAR; PG8_WAIT_L(0); PG8_MMA(0, 1, At, B1); PG8_BAR;
            PG8_LDA(At, 0, 1); PG8_STAGE(PG8_SA(0, 0), a2, voffA);
            PG8_BAR; PG8_WAIT_L(0); PG8_MMA(1, 0, At, B0); PG8_BAR; PG8_SCHED;
            PG8_STAGE(PG8_SB(0, 1), b2 + hstepB, voffB);
            PG8_WAIT_V(6); PG8_BAR; PG8_MMA(1, 1, At, B1); PG8_BAR;
            PG8_LDB(B0, 1, 0); PG8_SCHED; PG8_LDA(At, 1, 0); PG8_STAGE(PG8_SA(0, 1), a2 + hstepA, voffA);
            PG8_WAIT_L(8); PG8_BAR; PG8_WAIT_L(0); PG8_MMA(0, 0, At, B0); PG8_BAR; PG8_SCHED;
            PG8_LDB(B1, 1, 1); PG8_STAGE(PG8_SB(1, 0), b3, voffB);
            PG8_BAR; PG8_WAIT_L(0); PG8_MMA(0, 1, At, B1); PG8_BAR;
            PG8_LDA(At, 1, 1); PG8_STAGE(PG8_SA(1, 0), a3, voffA);
            PG8_BAR; PG8_WAIT_L(0); PG8_MMA(1, 0, At, B0); PG8_BAR; PG8_SCHED;
            PG8_STAGE(PG8_SB(1, 1), b3 + hstepB, voffB);
            PG8_WAIT_V(6); PG8_BAR; PG8_MMA(1, 1, At, B1); PG8_BAR;
            }
        }
        if constexpr (ALIGN_EPI) { if (wr == 0) PG8_BAR; }
        E(acc, cur, wr, wc, fr, fq); S.done(cur);
        if (!has_next) break;
#pragma unroll
        for (int a = 0; a < 2; ++a)
#pragma unroll
            for (int b = 0; b < 2; ++b)
#pragma unroll
                for (int m = 0; m < 4; ++m)
#pragma unroll
                    for (int n = 0; n < 2; ++n) acc[a][b][m][n] = (f32x4){0.f, 0.f, 0.f, 0.f};
        cur = nxt; cA = nA; cB = nB; ++ui;
        if constexpr (ALIGN_EPI) { if (wr == 1) PG8_BAR; }
    }
    PG8_WAIT_V(0);
    if constexpr (!ALIGN_EPI) { if (wr == 0) PG8_BAR; }
    PG8_BAR;
#undef PG8_UA
#undef PG8_UB
#undef PG8_SA
#undef PG8_SB
#undef PG8_STAGE
#undef PG8_LDA
#undef PG8_LDB
#undef PG8_MMA
#undef PG8_WAIT_V
#undef PG8_WAIT_L
#undef PG8_BAR
#undef PG8_SCHED
}
}

namespace atty {
using bf16 = __hip_bfloat16;
using bf16x8 = __attribute__((ext_vector_type(8))) short;
using s16x4  = __attribute__((ext_vector_type(4))) short;
using f32x16 = __attribute__((ext_vector_type(16))) float;
using u32x4  = __attribute__((ext_vector_type(4))) unsigned;
#define ATY_LAS __attribute__((address_space(3)))
constexpr int QBLK = 32, KVBLK = 64, UROWS = 128;
constexpr float SCALE = 0.088388347648318440f;
constexpr float THR = 8.f, THRL = THR * 1.4426950408889634f;
constexpr float QSCALE = SCALE * 1.4426950408889634f;
constexpr int LDQ = 128, LDK = 128, LDV = 256, LDO = 4096, LDZ = 4096 + 64;
constexpr int KBUF = 16384, VBUF = 32768, PBUF = 16384;
constexpr int LDS_K = 0, LDS_V = 2 * KBUF, LDS_P = LDS_V + 2 * VBUF, LDS_AL = LDS_P + 2 * PBUF, LDS_LI = LDS_AL + 2 * 4 * 128, LDS_END = LDS_LI + 4 * 128;
#define SBAR() __builtin_amdgcn_sched_barrier(0)
__device__ __forceinline__ int crow(int r, int hi) { return (r & 3) + 8 * (r >> 2) + 4 * hi; }
__device__ __forceinline__ unsigned cvtpk(float lo, float hi) { unsigned r; asm volatile("v_cvt_pk_bf16_f32 %0, %1, %2" : "=v"(r) : "v"(lo), "v"(hi)); return r; }
__device__ __forceinline__ unsigned rfl(unsigned v) { return (unsigned)__builtin_amdgcn_readfirstlane((int)v); }
__device__ __forceinline__ void dma16(unsigned m0v, int voff, __amdgpu_buffer_rsrc_t srd, unsigned soff) {
  unsigned keep;
  asm volatile("s_nop 4\n\ts_mov_b32 %0, m0\n\ts_mov_b32 m0, %1\n\ts_nop 0\n\tbuffer_load_dwordx4 %2, %3, %4 offen lds\n\ts_mov_b32 m0, %0"
               : "=&s"(keep) : "s"(m0v), "v"(voff), "s"(srd), "s"(soff) : "memory");
}
constexpr int v_rd_off(int d0, int ks, int half) { return d0 * 512 + ks * 4096 + half * 2048; }
__device__ __forceinline__ int v_rd_base(int lane) { return ((lane & 3) << 3) | (((lane >> 2) & 3) << 6) | (((lane >> 4) & 1) << 5) | (((lane >> 5) & 1) << 8); }
template <int OFF> __device__ __forceinline__ s16x4 tr_read(int vb) {
  s16x4 r; asm volatile("ds_read_b64_tr_b16 %0, %1 offset:%2" : "=&v"(r) : "v"(vb), "i"(OFF) : "memory"); return r;
}
template <int BASE> __device__ __forceinline__ void pv_one(f32x16& od, int vb, bf16x8 pa0, bf16x8 pa1, bf16x8 pa2, bf16x8 pa3) {
  const s16x4 l0 = tr_read<BASE + v_rd_off(0, 0, 0)>(vb), h0 = tr_read<BASE + v_rd_off(0, 0, 1)>(vb), l1 = tr_read<BASE + v_rd_off(0, 1, 0)>(vb), h1 = tr_read<BASE + v_rd_off(0, 1, 1)>(vb);
  const s16x4 l2 = tr_read<BASE + v_rd_off(0, 2, 0)>(vb), h2 = tr_read<BASE + v_rd_off(0, 2, 1)>(vb), l3 = tr_read<BASE + v_rd_off(0, 3, 0)>(vb), h3 = tr_read<BASE + v_rd_off(0, 3, 1)>(vb);
  asm volatile("s_waitcnt lgkmcnt(0)" ::: "memory"); SBAR();
#define PK(L, H) (bf16x8){L[0], L[1], L[2], L[3], H[0], H[1], H[2], H[3]}
  od = __builtin_amdgcn_mfma_f32_32x32x16_bf16(pa0, PK(l0, h0), od, 0, 0, 0);
  od = __builtin_amdgcn_mfma_f32_32x32x16_bf16(pa1, PK(l1, h1), od, 0, 0, 0);
  od = __builtin_amdgcn_mfma_f32_32x32x16_bf16(pa2, PK(l2, h2), od, 0, 0, 0);
  od = __builtin_amdgcn_mfma_f32_32x32x16_bf16(pa3, PK(l3, h3), od, 0, 0, 0);
#undef PK
}

template <int MODE>
__device__ __forceinline__ void attn_unit(const bf16* __restrict__ Qb, const bf16* __restrict__ Kh, const bf16* __restrict__ Vh, bf16* __restrict__ Ob, int cmap, const bf16* __restrict__ Zb, bf16* __restrict__ Yb,
                                          float lam, const float* __restrict__ subg, float oscale, int NT, int jw, ATY_LAS unsigned char* lds) {
  const int tid = threadIdx.x, lane = tid & 63, r32 = lane & 31, hi = lane >> 5;
  const int wid = __builtin_amdgcn_readfirstlane(tid >> 6), grp = wid & 3; const bool swave = wid < 4;
  const unsigned lds0 = (unsigned)(uintptr_t)lds;
  const __amdgpu_buffer_rsrc_t srdK = __builtin_amdgcn_make_buffer_rsrc((void*)Kh, 0, 0x7fffffff, 0x00020000), srdV = __builtin_amdgcn_make_buffer_rsrc((void*)Vh, 0, 0x7fffffff, 0x00020000);
  int kvo[2], vvo[4];
#pragma unroll
  for (int e = 0; e < 2; ++e) { const int row = 8 * wid + 4 * e + (lane >> 4), ch = (lane & 15) ^ (row & 7); kvo[e] = (row * LDK + ch * 8) * 2; }
#pragma unroll
  for (int e = 0; e < 4; ++e) { const int pj = 4 * wid + e, hv = pj >> 4, j = pj & 15, sb = 2 * j + (lane >> 5), kk = (sb >> 2) * 8 + ((lane & 31) >> 2), c = (sb & 3) * 32 + (lane & 3) * 8;
    const int k = (kk & ~0xC) | ((kk & 4) << 1) | ((kk & 8) >> 1); vvo[e] = (k * LDV + hv * 128 + c) * 2; }
#define DMA_K(t, buf) do { if (MODE & 1) break; _Pragma("unroll") for (int e_ = 0; e_ < 2; ++e_) dma16(rfl(lds0 + LDS_K + (unsigned)(buf) * KBUF + (unsigned)(2 * wid + e_) * 1024u), kvo[e_], srdK, rfl((unsigned)(t) * (KVBLK * LDK * 2))); } while (0)
#define DMA_V(t, buf) do { if (MODE & 1) break; _Pragma("unroll") for (int e_ = 0; e_ < 4; ++e_) dma16(rfl(lds0 + LDS_V + (unsigned)(buf) * VBUF + (unsigned)(4 * wid + e_) * 1024u), vvo[e_], srdV, rfl((unsigned)(t) * (KVBLK * LDV * 2))); } while (0)
#define DMA_K1(t, buf, e_) do { if (MODE & 1) break; dma16(rfl(lds0 + LDS_K + (unsigned)(buf) * KBUF + (unsigned)(2 * wid + (e_)) * 1024u), kvo[e_], srdK, rfl((unsigned)(t) * (KVBLK * LDK * 2))); } while (0)
#define DMA_V1(t, buf, e_) do { if (MODE & 1) break; dma16(rfl(lds0 + LDS_V + (unsigned)(buf) * VBUF + (unsigned)(4 * wid + (e_)) * 1024u), vvo[e_], srdV, rfl((unsigned)(t) * (KVBLK * LDV * 2))); } while (0)
#define WAITV_BAR() asm volatile("s_waitcnt vmcnt(0) lgkmcnt(0)\n\ts_barrier" ::: "memory")
  const unsigned pofs = lds0 + LDS_P + (unsigned)grp * 4096u + (unsigned)lane * 16u;
  ATY_LAS float* al_l = (ATY_LAS float*)(lds + LDS_AL) + grp * 32;
  ATY_LAS float* li_l = (ATY_LAS float*)(lds + LDS_LI) + grp * 32;
  if (swave) {
    bf16x8 qr[8];
    { const __amdgpu_buffer_rsrc_t srdQ = __builtin_amdgcn_make_buffer_rsrc((void*)Qb, 0, 0x7fffffff, 0x00020000);
      const int qoff = ((grp * QBLK + r32) * LDQ + hi * 8) * 2;
#pragma unroll
      for (int d0 = 0; d0 < 8; ++d0) qr[d0] = __builtin_bit_cast(bf16x8, __builtin_amdgcn_raw_buffer_load_b128(srdQ, qoff + d0 * 32, 0, 0)); }
    if (!(MODE & 1)) {
#pragma unroll
      for (int e = 0; e < 4; ++e) { const int row = 16 * grp + 4 * e + (lane >> 4), ch = (lane & 15) ^ (row & 7); const int ko = (row * LDK + ch * 8) * 2;
        dma16(rfl(lds0 + LDS_K + (unsigned)(4 * grp + e) * 1024u), ko, srdK, 0u);
        if (NT > 1) dma16(rfl(lds0 + LDS_K + KBUF + (unsigned)(4 * grp + e) * 1024u), ko, srdK, rfl((unsigned)(KVBLK * LDK * 2))); } }
    unsigned kp0[4];
#pragma unroll
    for (int dd = 0; dd < 4; ++dd) kp0[dd] = lds0 + LDS_K + (unsigned)(r32 * 256 + (((dd * 16 + hi * 8) * 2) ^ ((r32 & 7) << 4)));
    float m_ref = 0.f, l_reg = 0.f;
    f32x16 negm = f32x16{}, pA0 = f32x16{}, pA1 = f32x16{}, pB0 = f32x16{}, pB1 = f32x16{};
#pragma unroll
    for (int d0 = 0; d0 < 8; ++d0) asm volatile("" : "+v"(qr[d0]));
    WAITV_BAR();
    __builtin_amdgcn_s_setprio(1);
#define ATY_QK(D0, D1, t, WITH_DMA, i) do { const unsigned kofs_ = (unsigned)((t) & 1) * KBUF; D0 = negm; D1 = negm; \
        _Pragma("unroll") for (int d0 = 0; d0 < 8; ++d0) { const unsigned a_ = kp0[d0 & 3] + kofs_ + (d0 >> 2) * 128; \
          const bf16x8 b0 = *(const ATY_LAS bf16x8*)(uintptr_t)a_; const bf16x8 b1 = *(const ATY_LAS bf16x8*)(uintptr_t)(a_ + 8192); \
          D0 = __builtin_amdgcn_mfma_f32_32x32x16_bf16(b0, qr[d0], D0, 0, 0, 0); \
          D1 = __builtin_amdgcn_mfma_f32_32x32x16_bf16(b1, qr[d0], D1, 0, 0, 0); \
          if (WITH_DMA) { if (d0 == 0 && dk) DMA_K1((i) + 2, (i) & 1, 0); if (d0 == 1 && dk) DMA_K1((i) + 2, (i) & 1, 1); if (d0 >= 2 && d0 < 6 && dv) DMA_V1((i), (i) & 1, d0 - 2); } } } while (0)
#define ATY_SM(P0, P1, N0, N1, i) do { \
        if (MODE & 64) { const unsigned pdst = pofs + (unsigned)((i) & 1) * PBUF; ATY_PK4(P0, 0, 0); ATY_PK4(P0, 8, 1); ATY_PK4(P1, 0, 2); ATY_PK4(P1, 8, 3); if (hi == 0) al_l[((i) & 1) * 128 + r32] = 1.f; break; } \
        float a0 = fmaxf(P0[0], P0[1]), a1 = fmaxf(P1[0], P1[1]); \
        _Pragma("unroll") for (int r = 2; r < 16; r += 2) { a0 = fmaxf(fmaxf(a0, P0[r]), P0[r + 1]); a1 = fmaxf(fmaxf(a1, P1[r]), P1[r + 1]); } \
        float pmax = fmaxf(a0, a1); \
        { auto rr = __builtin_amdgcn_permlane32_swap(__float_as_uint(pmax), __float_as_uint(pmax), false, false); \
          pmax = fmaxf(__uint_as_float(rr[0]), __uint_as_float(rr[1])); } \
        float alpha = 1.f; \
        if (__builtin_expect((i) == 0 || __any(pmax > THRL), 0)) {          \
          const float dl = ((i) == 0) ? pmax : fmaxf(pmax, 0.f); \
          m_ref += dl; alpha = ((i) == 0) ? 1.f : __builtin_amdgcn_exp2f(-dl); \
          _Pragma("unroll") for (int r = 0; r < 16; ++r) { P0[r] -= dl; P1[r] -= dl; N0[r] -= dl; N1[r] -= dl; negm[r] = -m_ref; } } \
        _Pragma("unroll") for (int r = 0; r < 16; ++r) { P0[r] = __builtin_amdgcn_exp2f(P0[r]); P1[r] = __builtin_amdgcn_exp2f(P1[r]); } \
        float s0 = P0[0], s1 = P0[1], s2 = P1[0], s3 = P1[1]; \
        _Pragma("unroll") for (int r = 2; r < 16; r += 2) { s0 += P0[r]; s1 += P0[r + 1]; s2 += P1[r]; s3 += P1[r + 1]; } \
        float ps = (s0 + s1) + (s2 + s3); \
        { auto rr = __builtin_amdgcn_permlane32_swap(__float_as_uint(ps), __float_as_uint(ps), false, false); \
          ps = __uint_as_float(rr[0]) + __uint_as_float(rr[1]); } \
        l_reg = l_reg * alpha + ps; \
        const unsigned pdst = pofs + (unsigned)((i) & 1) * PBUF; \
        ATY_PK4(P0, 0, 0); ATY_PK4(P0, 8, 1); ATY_PK4(P1, 0, 2); ATY_PK4(P1, 8, 3); \
        if (hi == 0) al_l[((i) & 1) * 128 + r32] = alpha; } while (0)
#define ATY_PK4(P, BASE, KS) do { unsigned a0_ = cvtpk(P[BASE + 0], P[BASE + 1]), a1_ = cvtpk(P[BASE + 2], P[BASE + 3]);   \
    unsigned b0_ = cvtpk(P[BASE + 4], P[BASE + 5]), b1_ = cvtpk(P[BASE + 6], P[BASE + 7]);                              \
    auto r0 = __builtin_amdgcn_permlane32_swap(a0_, b0_, false, false); auto r1 = __builtin_amdgcn_permlane32_swap(a1_, b1_, false, false); \
    u32x4 w = {r0[0], r1[0], r0[1], r1[1]}; *(ATY_LAS u32x4*)(uintptr_t)(pdst + (KS) * 1024u) = w; } while (0)
#define ATY_SBODY(C0, C1, N0, N1, i) do { const bool dk = ((i) + 2 < NT), dv = ((i) < NT); \
      if ((i) <= jw && !(MODE & 6)) { \
        if ((i) + 1 <= jw) ATY_QK(N0, N1, (i) + 1, true, i); else { if (dk) DMA_K((i) + 2, (i) & 1); if (dv) DMA_V((i), (i) & 1); } \
        ATY_SM(C0, C1, N0, N1, i); \
      } else { if (dk) DMA_K((i) + 2, (i) & 1); if (dv) DMA_V((i), (i) & 1); } \
      WAITV_BAR(); } while (0)
    if (!(MODE & 6)) { const bool dk = false, dv = false; ATY_QK(pA0, pA1, 0, false, 0); (void)dk; (void)dv; }
    WAITV_BAR();
#pragma unroll 1
    for (int i = 0; i < NT; i += 2) {
      ATY_SBODY(pA0, pA1, pB0, pB1, i);
      ATY_SBODY(pB0, pB1, pA0, pA1, i + 1);
    }
    WAITV_BAR();
#undef ATY_QK
#undef ATY_SM
#undef ATY_PK4
#undef ATY_SBODY
    __builtin_amdgcn_s_setprio(0);
    if (hi == 0) li_l[r32] = l_reg;
    WAITV_BAR();
  } else {
    f32x16 o[8];
#pragma unroll
    for (int d = 0; d < 8; ++d) o[d] = f32x16{};
    const int vb0 = (int)(lds0 + LDS_V) + v_rd_base(lane);
    WAITV_BAR();
    WAITV_BAR();
#pragma unroll 1
    for (int i = 0; i <= NT; ++i) {
      if (i + 2 < NT) DMA_K(i + 2, i & 1);
      if (i < NT) DMA_V(i, i & 1);
      const int t = i - 1;
      if (t >= 0 && t <= jw && !(MODE & 10)) {
        const int b = t & 1;
        const int vb = vb0 + b * VBUF;
        s16x4 EXl0 = {}, EXh0 = {}, EXl1 = {}, EXh1 = {}, EYl0 = {}, EYh0 = {}, EYl1 = {}, EYh1 = {}, FXl0 = {}, FXh0 = {}, FXl1 = {}, FXh1 = {}, FYl0 = {}, FYh0 = {}, FYl1 = {}, FYh1 = {};
#define VRH(S, BX, BY, H) do { if (MODE & 32) { asm volatile("" : "+v"(S##Xl0), "+v"(S##Xh0), "+v"(S##Xl1), "+v"(S##Xh1), "+v"(S##Yl0), "+v"(S##Yh0), "+v"(S##Yl1), "+v"(S##Yh1)); break; } \
        S##Xl0 = tr_read<BX + v_rd_off(0, 2 * H, 0)>(vb); S##Xh0 = tr_read<BX + v_rd_off(0, 2 * H, 1)>(vb); S##Yl0 = tr_read<BY + v_rd_off(0, 2 * H, 0)>(vb); S##Yh0 = tr_read<BY + v_rd_off(0, 2 * H, 1)>(vb); \
        S##Xl1 = tr_read<BX + v_rd_off(0, 2 * H + 1, 0)>(vb); S##Xh1 = tr_read<BX + v_rd_off(0, 2 * H + 1, 1)>(vb); S##Yl1 = tr_read<BY + v_rd_off(0, 2 * H + 1, 0)>(vb); S##Yh1 = tr_read<BY + v_rd_off(0, 2 * H + 1, 1)>(vb); } while (0)
#define PKV(L, H) (bf16x8){L[0], L[1], L[2], L[3], H[0], H[1], H[2], H[3]}
#define VMH(S, ox, oy, PA, PB) do { ox = __builtin_amdgcn_mfma_f32_32x32x16_bf16(PA, PKV(S##Xl0, S##Xh0), ox, 0, 0, 0); oy = __builtin_amdgcn_mfma_f32_32x32x16_bf16(PA, PKV(S##Yl0, S##Yh0), oy, 0, 0, 0); \
                                   ox = __builtin_amdgcn_mfma_f32_32x32x16_bf16(PB, PKV(S##Xl1, S##Xh1), ox, 0, 0, 0); oy = __builtin_amdgcn_mfma_f32_32x32x16_bf16(PB, PKV(S##Yl1, S##Yh1), oy, 0, 0, 0); } while (0)
#define LW0() do { SBAR(); asm volatile("s_waitcnt lgkmcnt(0)" ::: "memory"); SBAR(); } while (0)
#define BLK(d) (((d) >> 2) * 16384 + ((d) & 3) * 512)
        VRH(E, BLK(0), BLK(1), 0);
        const float am = al_l[b * 128 + r32];
        const unsigned psrc = pofs + (unsigned)b * PBUF;
        const bf16x8 pa0 = *(const ATY_LAS bf16x8*)(uintptr_t)(psrc), pa1 = *(const ATY_LAS bf16x8*)(uintptr_t)(psrc + 1024u);
        const bf16x8 pa2 = *(const ATY_LAS bf16x8*)(uintptr_t)(psrc + 2048u), pa3 = *(const ATY_LAS bf16x8*)(uintptr_t)(psrc + 3072u);
        if (__any(am < 1.f)) {
          asm volatile("s_waitcnt lgkmcnt(0)" ::: "memory");
#pragma unroll
          for (int r = 0; r < 16; ++r) { const float f = al_l[b * 128 + crow(r, hi)];
#pragma unroll
            for (int d = 0; d < 8; ++d) o[d][r] *= f; } }
        LW0();
        VRH(F, BLK(0), BLK(1), 1); VMH(E, o[0], o[1], pa0, pa1); LW0();
        VRH(E, BLK(2), BLK(3), 0); VMH(F, o[0], o[1], pa2, pa3); LW0();
        VRH(F, BLK(2), BLK(3), 1); VMH(E, o[2], o[3], pa0, pa1); LW0();
        VRH(E, BLK(4), BLK(5), 0); VMH(F, o[2], o[3], pa2, pa3); LW0();
        VRH(F, BLK(4), BLK(5), 1); VMH(E, o[4], o[5], pa0, pa1); LW0();
        VRH(E, BLK(6), BLK(7), 0); VMH(F, o[4], o[5], pa2, pa3); LW0();
        VRH(F, BLK(6), BLK(7), 1); VMH(E, o[6], o[7], pa0, pa1); LW0();
        VMH(F, o[6], o[7], pa2, pa3);
#undef VRH
#undef VMH
#undef BLK
#undef PKV
#undef LW0
      }
      WAITV_BAR();
    }
    WAITV_BAR();
    float rli[16];
#pragma unroll
    for (int r = 0; r < 16; ++r) rli[r] = __builtin_amdgcn_rcpf(li_l[crow(r, hi)]);
    { ATY_LAS unsigned short* stg = (ATY_LAS unsigned short*)(lds + LDS_V + grp * 16384);
#pragma unroll
      for (int r = 0; r < 16; ++r) { const int orow = crow(r, hi);
#pragma unroll
        for (int d = 0; d < 8; ++d) { const float v = o[d][r] * rli[r]; stg[orow * 256 + d * 32 + r32] = (unsigned short)(cvtpk(v, v) & 0xffffu); } }
      asm volatile("s_waitcnt lgkmcnt(0)" ::: "memory");
      const __amdgpu_buffer_rsrc_t srdO = __builtin_amdgcn_make_buffer_rsrc((void*)Ob, 0, 0x7fffffff, 0x00020000);
      int tz = lane; asm volatile("" : "+v"(tz));
      const unsigned rb = (unsigned)(uintptr_t)stg + (unsigned)((tz >> 5) * 512 + (tz & 31) * 16);
      const int gb = ((grp * QBLK + (tz >> 5)) * LDO + (tz & 31) * 8) * 2;
      if (cmap == 0) {
#pragma unroll
        for (int i = 0; i < 16; ++i) { const u32x4 v = *(const ATY_LAS u32x4*)(uintptr_t)(rb + i * 1024);
          __builtin_amdgcn_raw_buffer_store_b128(v, srdO, gb, i * (2 * LDO * 2), 0); }
      } else {
        const __amdgpu_buffer_rsrc_t srdZ = __builtin_amdgcn_make_buffer_rsrc((void*)Zb, 0, 0x7fffffff, 0x00020000), srdY = __builtin_amdgcn_make_buffer_rsrc((void*)Yb, 0, 0x7fffffff, 0x00020000);
        const int gz = ((grp * QBLK + (tz >> 5)) * LDZ + (tz & 31) * 8) * 2;
        float g8[8];
        { const float* gp = subg + (tz & 31) * 8;
#pragma unroll
          for (int e = 0; e < 8; ++e) g8[e] = gp[e] * oscale; }
#pragma unroll 2
        for (int i = 0; i < 16; ++i) {
          const u32x4 v1 = *(const ATY_LAS u32x4*)(uintptr_t)(rb + i * 1024);
          const u32x4 v0 = __builtin_amdgcn_raw_buffer_load_b128(srdO, gb, i * (2 * LDO * 2), 16);
          const u32x4 vz = __builtin_amdgcn_raw_buffer_load_b128(srdZ, gz, i * (2 * LDZ * 2), 0);
          float o[8]; float ss = 0.f;
#pragma unroll
          for (int e = 0; e < 4; ++e) { const float a0 = __uint_as_float(v0[e] << 16), a1 = __uint_as_float(v0[e] & 0xffff0000u), b0 = __uint_as_float(v1[e] << 16), b1 = __uint_as_float(v1[e] & 0xffff0000u);
            o[2 * e] = a0 - lam * b0; o[2 * e + 1] = a1 - lam * b1; ss += o[2 * e] * o[2 * e] + o[2 * e + 1] * o[2 * e + 1]; }
#pragma unroll
          for (int sh = 1; sh < 32; sh <<= 1) ss += __shfl_xor(ss, sh);
          const float rstd = 1.0f / sqrtf(ss * (1.f / 256.f) + 1e-6f);
          u32x4 w;
#pragma unroll
          for (int e = 0; e < 4; ++e) { const float z0 = __uint_as_float(vz[e] << 16), z1 = __uint_as_float(vz[e] & 0xffff0000u);
            const float y0 = o[2 * e] * rstd * g8[2 * e] * (z0 * __builtin_amdgcn_rcpf(1.0f + __builtin_amdgcn_exp2f(-1.4426950408889634f * z0)));
            const float y1 = o[2 * e + 1] * rstd * g8[2 * e + 1] * (z1 * __builtin_amdgcn_rcpf(1.0f + __builtin_amdgcn_exp2f(-1.4426950408889634f * z1)));
            w[e] = cvtpk(y0, y1); }
          __builtin_amdgcn_raw_buffer_store_b128(w, srdY, gz, i * (2 * LDZ * 2), 0); }
      } }
  }
#undef DMA_K
#undef DMA_V
#undef DMA_K1
#undef DMA_V1
#undef WAITV_BAR
}
#undef SBAR
}

constexpr int NWAVES = 8;
constexpr int S_ = 8192, DM = 4096, PW = 8192, PG = 2048, AW = 4096, NH = 16, DH = 128;
constexpr int P4K = 4096 + 64, P8K = 8192 + 64, P2K = 2048 + 64;
constexpr float EPS = 1e-6f;
constexpr float LAM_INIT = 0.35550906759096934f;

constexpr size_t MiB = 1u << 20;
constexpr size_t WS_CTL = 0, CTL_ZERO_BYTES = 1 * MiB;
constexpr size_t WS_ADA = 1 * MiB;
constexpr size_t WS_COS = 2 * MiB, WS_SIN = 4 * MiB;
constexpr size_t WS_W_IN = 8 * MiB;
constexpr size_t WS_W_GRP = 138 * MiB;
constexpr size_t WS_W_OUTA = 171 * MiB;
constexpr size_t WS_W_KVQG = 236 * MiB;
constexpr size_t WS_W_OUTB = 366 * MiB;
constexpr size_t WS_H1 = 399 * MiB;
constexpr size_t WS_HN = 527 * MiB;
constexpr size_t WS_UZ = 592 * MiB;
constexpr size_t WS_W_INU = 848 * MiB;
constexpr size_t WS_Y = 977 * MiB;
constexpr size_t WS_KVN = 527 * MiB;
constexpr size_t WS_HNB = 592 * MiB;
constexpr size_t WS_K = 657 * MiB, WS_V = 722 * MiB, WS_Q = 787 * MiB, WS_Z = 852 * MiB;
constexpr size_t WS_OC = 917 * MiB;
constexpr size_t WS_YB = 1045 * MiB;
constexpr size_t WS_END = 1110 * MiB;
static_assert((size_t)S_ * P4K * 2 == 65 * MiB && (size_t)S_ * P8K * 2 == 129 * MiB && (size_t)4 * PG * P2K * 2 == 33 * MiB, "padded buffer sizes");
constexpr int CW_BAR = 4096;

constexpr int RING_OFF = 0;
constexpr int LDSCTL_OFF = 143360, MISC_OFF = LDSCTL_OFF + 320;
constexpr int LDS_BYTES = 147456;

#define GAS __attribute__((address_space(1)))
#define LAS __attribute__((address_space(3)))
typedef unsigned short bf16;
typedef unsigned v4u __attribute__((ext_vector_type(4)));
typedef unsigned v2u __attribute__((ext_vector_type(2)));
typedef float f32x4 __attribute__((ext_vector_type(4)));
typedef GAS unsigned gu32;
#define RLX_AGENT __ATOMIC_RELAXED, __HIP_MEMORY_SCOPE_AGENT
#define LDS_WAIT() asm volatile("s_waitcnt lgkmcnt(0)" ::: "memory")
#define VM_WAIT() asm volatile("s_waitcnt vmcnt(0)" ::: "memory")
__device__ __forceinline__ unsigned pk2(float lo, float hi) { return pg8::cvt_pk_bf16(lo, hi); }

#define XB_TMO      128
#define XB_XCNT(j)  (256  + 64 * (j))
#define XB_XSUB(j)  (1280 + 64 * (j))
#define XB_XGEN(j)  (2304 + 64 * (j))
#define XB_TOP      3328
#define XB_TOPGEN   3392
#define XCD_BAR_WORDS 3456
#define XB_SPIN_CAP (1u << 18)

__device__ __forceinline__ unsigned xb_ld(unsigned* p)              { return __hip_atomic_load(p, __ATOMIC_RELAXED, __HIP_MEMORY_SCOPE_AGENT); }
__device__ __forceinline__ unsigned xb_add(unsigned* p, unsigned v) { return __hip_atomic_fetch_add(p, v, __ATOMIC_RELAXED, __HIP_MEMORY_SCOPE_AGENT); }
__device__ __forceinline__ unsigned xb_xcc_id() { return (unsigned)__builtin_amdgcn_s_getreg((3 << 11) | 20) & 0xFu; }
#define XB_SPIN(cond, bar) do { unsigned _sp = 0; while (cond) { __builtin_amdgcn_s_sleep(1); \
    if ((++_sp & 255u) == 0u) { if (xb_ld(&(bar)[XB_TMO])) break; if (_sp > XB_SPIN_CAP) { atomicAdd(&(bar)[XB_TMO], 1u); break; } } } } while (0)

struct XcdBarrier { unsigned* bar; unsigned x; volatile LAS unsigned* st; };

__device__ __forceinline__ XcdBarrier xcd_barrier_post(unsigned* bar, volatile LAS unsigned* st) {
    XcdBarrier b; b.bar = bar; b.x = xb_xcc_id(); b.st = st;
    if (threadIdx.x == 0) (void)xb_add(&bar[XB_XCNT(b.x)], 1u);
    return b;
}
__device__ __forceinline__ void xcd_barrier_complete(unsigned* bar, unsigned x, unsigned& nloc, unsigned& nx) {
    const unsigned G = gridDim.x * gridDim.y * gridDim.z;
    unsigned sum, cnt, mine, sp = 0u;
    for (;;) {
        sum = 0u; cnt = 0u; mine = 0u;
#pragma unroll
        for (unsigned j = 0; j < 16; ++j) { const unsigned c = xb_ld(&bar[XB_XCNT(j)]); sum += c; cnt += (c > 0u) ? 1u : 0u; mine = (j == x) ? c : mine; }
        if (sum == G) break;
        __builtin_amdgcn_s_sleep(1);
        if ((++sp & 255u) == 0u) { if (xb_ld(&bar[XB_TMO])) break; if (sp > XB_SPIN_CAP) { atomicAdd(&bar[XB_TMO], 1u); break; } }
    }
    nloc = mine > 0u ? mine : 1u; nx = cnt > 0u ? cnt : 1u;
}
__device__ __forceinline__ void xcd_barrier(const XcdBarrier& b) {
    asm volatile("s_waitcnt vmcnt(0)" ::: "memory");
    __syncthreads();
    if (threadIdx.x == 0) {
        unsigned* bar = b.bar;
        __builtin_amdgcn_s_waitcnt(0);
        unsigned nloc = b.st[0], nx = b.st[1];
        if (nloc == 0u) { xcd_barrier_complete(bar, b.x, nloc, nx); b.st[0] = nloc; b.st[1] = nx; }
        const unsigned old = xb_add(&bar[XB_XSUB(b.x)], 1u);
        const unsigned gen = old / nloc;
        if (old + 1u == (gen + 1u) * nloc) {
            __builtin_amdgcn_fence(__ATOMIC_RELEASE, "agent");
            asm volatile("s_waitcnt vmcnt(0)" ::: "memory");
            const unsigned og = xb_add(&bar[XB_TOP], 1u);
            const unsigned tg = og / nx;
            if (og + 1u == (tg + 1u) * nx) xb_add(&bar[XB_TOPGEN], 1u);
            else XB_SPIN(xb_ld(&bar[XB_TOPGEN]) == tg, bar);
            __builtin_amdgcn_fence(__ATOMIC_ACQUIRE, "agent");
            xb_add(&bar[XB_XGEN(b.x)], 1u);
            asm volatile("s_waitcnt vmcnt(0)" ::: "memory");
        } else {
            XB_SPIN(xb_ld(&bar[XB_XGEN(b.x)]) == gen, bar);
            __builtin_amdgcn_fence(__ATOMIC_ACQUIRE, "agent");
            asm volatile("s_waitcnt vmcnt(0)" ::: "memory");
        }
    }
    __syncthreads();
}

struct Frame {
    LAS unsigned char* lds;
    volatile LAS unsigned* MISC;
    gu32* ctl;
    int tid, lane, wave;
    int vcu, G;
};
struct Args {
    const float* x; const float* c; const int* pos;
    const float* a_norm_g; const float* a_ada_w; const float* a_ada_b; const float* a_w_in; const float* a_w_group; const float* a_scale; const float* a_w_out;
    const float* kv_norm_g; const float* kv_ada_w; const float* kv_ada_b; const float* w_kv;
    const float* b_norm_g; const float* b_ada_w; const float* b_ada_b; const float* b_w_qg; const float* b_lam; const float* b_subln_g; const float* b_w_out; const float* final_g;
    float* out; unsigned char* ws; int ph_lo, ph_hi, li, pad;
};

__device__ __forceinline__ float wave_sum(float v) {
#pragma unroll
    for (int o = 1; o < 64; o <<= 1) v += __shfl_xor(v, o);
    return v;
}
__device__ __forceinline__ float half_sum(float v) {
#pragma unroll
    for (int o = 1; o < 32; o <<= 1) v += __shfl_xor(v, o);
    return v;
}

__device__ __forceinline__ void p0_ada(Frame& F, const Args& a) {
    LAS float* sc = (LAS float*)(F.lds + RING_OFF);
    LAS float* part = sc + 4096;
    for (int k = F.tid; k < DM; k += NWAVES * 64) { const float c = a.c[k]; sc[k] = pg8::silu_f(c); }
    __syncthreads();
    float* mall = (float*)(a.ws + WS_ADA);
    const int cg = F.lane & 31, kp = F.lane >> 5;
    for (int slab = blockIdx.x; slab < 256; slab += F.G) {
        const int j0 = slab * 128;
        const float* W; const float* bias; int N, c0;
        if (j0 < 12288) { W = a.a_ada_w; bias = a.a_ada_b; N = 12288; c0 = j0; }
        else if (j0 < 20480) { W = a.kv_ada_w; bias = a.kv_ada_b; N = 8192; c0 = j0 - 12288; }
        else { W = a.b_ada_w; bias = a.b_ada_b; N = 12288; c0 = j0 - 20480; }
        const float* wp = W + (size_t)(512 * F.wave + kp) * N + c0 + 4 * cg;
        const LAS float* sp = sc + 512 * F.wave + kp;
        f32x4 acc = (f32x4){0.f, 0.f, 0.f, 0.f};
#pragma unroll 16
        for (int i = 0; i < 256; ++i) { const f32x4 wv = *(const GAS f32x4*)(wp + (size_t)(2 * i) * N); acc += sp[2 * i] * wv; }
#pragma unroll
        for (int e = 0; e < 4; ++e) acc[e] += __shfl_xor(acc[e], 32);
        if (kp == 0) { LAS float* pp = part + F.wave * 128 + 4 * cg; pp[0] = acc[0]; pp[1] = acc[1]; pp[2] = acc[2]; pp[3] = acc[3]; }
        __syncthreads();
        if (F.tid < 128) { float s = bias[c0 + F.tid];
#pragma unroll
            for (int w = 0; w < 8; ++w) s += part[w * 128 + F.tid];
            mall[j0 + F.tid] = s; }
        __syncthreads();
    }
}
__device__ __forceinline__ void p0_rope(Frame& F, const Args& a) {
    float* cs = (float*)(a.ws + WS_COS); float* sn = (float*)(a.ws + WS_SIN);
    const int gt = blockIdx.x * (NWAVES * 64) + F.tid, NT = F.G * NWAVES * 64;
    for (int idx = gt; idx < S_ * 64; idx += NT) {
        const int row = idx >> 6, i = idx & 63;
        double inv = 1.0, b = 0.8659643233600653; int e = i;
        while (e) { if (e & 1) inv *= b; b *= b; e >>= 1; }
        const double ang = (double)a.pos[row] * inv;
        const double kq = rint(ang * 0.63661977236758134308);
        double r = fma(-kq, 1.5707963267948966, ang); r = fma(-kq, 6.123233995736766e-17, r);
        const double r2 = r * r;
        double sp = -7.6471637318198164759e-13; sp = fma(sp, r2, 1.6059043836821614599e-10); sp = fma(sp, r2, -2.5052108385441718775e-8); sp = fma(sp, r2, 2.7557319223985890653e-6);
        sp = fma(sp, r2, -1.9841269841269841270e-4); sp = fma(sp, r2, 8.3333333333333333333e-3); sp = fma(sp, r2, -1.6666666666666666667e-1); sp = fma(sp * r2, r, r);
        double cp = 4.7794773323873852974e-14; cp = fma(cp, r2, -1.1470745597729724714e-11); cp = fma(cp, r2, 2.0876756987868098979e-9); cp = fma(cp, r2, -2.7557319223985890653e-7);
        cp = fma(cp, r2, 2.4801587301587301587e-5); cp = fma(cp, r2, -1.3888888888888888889e-3); cp = fma(cp, r2, 4.1666666666666666667e-2); cp = fma(cp, r2, -0.5); cp = fma(cp, r2, 1.0);
        const int q = ((int)kq) & 3;
        const double sv = (q == 0) ? sp : (q == 1) ? cp : (q == 2) ? -sp : -cp;
        const double cv = (q == 0) ? cp : (q == 1) ? -sp : (q == 2) ? -cp : sp;
        cs[idx] = (float)cv; sn[idx] = (float)sv;
    }
}
template <bool ROPE>
__device__ __forceinline__ void p0_transpose_item(const float* W, int K, int N, int ldw, bf16* WT, int ldt, int row_off, LAS float* scr, int item, int lane) {
    const int nblk = N / 64, kb = item / nblk, nb = item % nblk, k0 = 64 * kb, n0 = 64 * nb;
    f32x4 v[16];
    const float* wp = W + (size_t)(k0 + (lane >> 4)) * ldw + n0 + 4 * (lane & 15);
#pragma unroll
    for (int i = 0; i < 16; ++i) v[i] = *(const GAS f32x4*)(wp + (size_t)(4 * i) * ldw);
#pragma unroll
    for (int i = 0; i < 16; ++i) { LAS float* s = scr + (4 * i + (lane >> 4)) * 65 + 4 * (lane & 15); s[0] = v[i][0]; s[1] = v[i][1]; s[2] = v[i][2]; s[3] = v[i][3]; }
    LDS_WAIT(); asm volatile("" ::: "memory");
    const int c = lane & 7;
#pragma unroll
    for (int j = 0; j < 8; ++j) { const int n = (lane >> 3) + 8 * j; const LAS float* s = scr + (8 * c) * 65 + n;
        v4u o; o.x = pk2(s[0 * 65], s[1 * 65]); o.y = pk2(s[2 * 65], s[3 * 65]); o.z = pk2(s[4 * 65], s[5 * 65]); o.w = pk2(s[6 * 65], s[7 * 65]);
        int ng = n0 + n;
        if (ROPE && ng < 4096) { const int p = ng & 127; ng = (ng & ~127) + ((p < 64) ? 2 * p : 2 * (p - 64) + 1); }
        *(GAS v4u*)(WT + (size_t)(row_off + ng) * ldt + k0 + 8 * c) = o; }
    LDS_WAIT(); asm volatile("" ::: "memory");
}
__device__ __forceinline__ void p0_copy_item(const float* W, int ldw, bf16* O, int ldo, int item, int lane) {
    const int row = item >> 3, seg = item & 7;
    const GAS f32x4* wp = (const GAS f32x4*)(W + (size_t)row * ldw + seg * 1024 + lane * 16);
    const f32x4 a = wp[0], b = wp[1], c = wp[2], d = wp[3];
    GAS v4u* op = (GAS v4u*)(O + (size_t)row * ldo + seg * 1024 + lane * 16);
    v4u o0, o1; o0.x = pk2(a.x, a.y); o0.y = pk2(a.z, a.w); o0.z = pk2(b.x, b.y); o0.w = pk2(b.z, b.w); o1.x = pk2(c.x, c.y); o1.y = pk2(c.z, c.w); o1.z = pk2(d.x, d.y); o1.w = pk2(d.z, d.w);
    op[0] = o0; op[1] = o1;
}
__device__ __forceinline__ void p0_convert(Frame& F, const Args& a) {
    LAS float* scr = (LAS float*)(F.lds + RING_OFF) + F.wave * (64 * 65);
    const int gw = F.vcu * NWAVES + F.wave, NGW = F.G * NWAVES;
    constexpr int I_INZ = (DM / 64) * (PW / 64), I_GRP = (PG / 64) * (PG / 64), I_OA = (PW / 64) * (DM / 64), I_KV = (DM / 64) * (2 * AW / 64), I_OB = (AW / 64) * (DM / 64);
    constexpr int I_INU = DM * 8;
    constexpr int NITEMS = I_INZ + 4 * I_GRP + I_OA + 2 * I_KV + I_OB;
    unsigned char* ws = a.ws;
    for (int it = gw; it < I_INU; it += NGW) p0_copy_item(a.a_w_in, 2 * PW, (bf16*)(ws + WS_W_INU), P8K, it, F.lane);
    for (int it = gw; it < NITEMS; it += NGW) {
        int r = it;
        if (r < 4 * I_GRP) { const int g = r / I_GRP; p0_transpose_item<false>(a.a_w_group + (size_t)g * PG * PG, PG, PG, PG, (bf16*)(ws + WS_W_GRP), P2K, g * PG, scr, r % I_GRP, F.lane); continue; } r -= 4 * I_GRP;
        if (r < I_INZ) { p0_transpose_item<false>(a.a_w_in + PW, DM, PW, 2 * PW, (bf16*)(ws + WS_W_IN), P4K, PW, scr, r, F.lane); continue; } r -= I_INZ;
        if (r < I_OA) { p0_transpose_item<false>(a.a_w_out, PW, DM, DM, (bf16*)(ws + WS_W_OUTA), P8K, 0, scr, r, F.lane); continue; } r -= I_OA;
        if (r < I_KV) { p0_transpose_item<true>(a.w_kv, DM, 2 * AW, 2 * AW, (bf16*)(ws + WS_W_KVQG), P4K, 0, scr, r, F.lane); continue; } r -= I_KV;
        if (r < I_KV) { p0_transpose_item<true>(a.b_w_qg, DM, 2 * AW, 2 * AW, (bf16*)(ws + WS_W_KVQG), P4K, 2 * AW, scr, r, F.lane); continue; } r -= I_KV;
        p0_transpose_item<false>(a.b_w_out, AW, DM, DM, (bf16*)(ws + WS_W_OUTB), P4K, 0, scr, r, F.lane);
    }
}
template <int NOUT>
__device__ __forceinline__ void norm_mod_rows(Frame& F, const float* xin, bf16* out0, bf16* out1, const LAS float* tab) {
    const int gw = F.vcu * NWAVES + F.wave, NGW = F.G * NWAVES;
    for (int m = gw; m < S_; m += NGW) {
        const GAS f32x4* xr = (const GAS f32x4*)(xin + (size_t)m * DM) + F.lane;
        f32x4 v[16]; float s = 0.f;
#pragma unroll
        for (int j = 0; j < 16; ++j) { v[j] = xr[64 * j]; s += (v[j].x * v[j].x + v[j].y * v[j].y) + (v[j].z * v[j].z + v[j].w * v[j].w); }
        const float rstd = 1.0f / sqrtf(wave_sum(s) * (1.f / DM) + EPS);
#pragma unroll
        for (int o = 0; o < NOUT; ++o) {
            GAS v2u* op = (GAS v2u*)((o == 0 ? out0 : out1) + (size_t)m * P4K) + F.lane;
            const LAS f32x4* gs = (const LAS f32x4*)(tab + o * 2 * DM) + F.lane; const LAS f32x4* sh = (const LAS f32x4*)(tab + o * 2 * DM + DM) + F.lane;
#pragma unroll
            for (int j = 0; j < 16; ++j) { const f32x4 g = gs[64 * j], h = sh[64 * j]; const f32x4 y = v[j] * rstd * g + h;
                v2u w; w.x = pk2(y.x, y.y); w.y = pk2(y.z, y.w); op[64 * j] = w; }
        }
    }
}
__device__ __forceinline__ void unpack8(const v4u u, float* f) {
    f[0] = pg8::bf_lo(u.x); f[1] = pg8::bf_hi(u.x); f[2] = pg8::bf_lo(u.y); f[3] = pg8::bf_hi(u.y); f[4] = pg8::bf_lo(u.z); f[5] = pg8::bf_hi(u.z); f[6] = pg8::bf_lo(u.w); f[7] = pg8::bf_hi(u.w);
}
__device__ __forceinline__ void p3_pool(Frame& F, const Args& a) {
    const bf16* __restrict__ U = (const bf16*)(a.ws + WS_UZ); bf16* __restrict__ P = (bf16*)(a.ws + WS_Y);
    const int gt = F.vcu * (NWAVES * 64) + F.tid, NT = F.G * NWAVES * 64;
    constexpr int RB = 32, NCH = PW / 8, NITEM = (S_ / RB) * NCH, LDU = 2 * PW;
    for (int it = gt; it < NITEM; it += NT) {
        const int ch = it % NCH, rb = it / NCH, t0 = rb * RB, w = 2 << (ch >> 8);
        const bf16* up = U + (size_t)ch * 8; bf16* pp = P + (size_t)ch * 8;
        float sc[8];
        { const f32x4 s0 = *(const GAS f32x4*)(a.a_scale + ch * 8), s1 = *(const GAS f32x4*)(a.a_scale + ch * 8 + 4);
          sc[0] = s0.x; sc[1] = s0.y; sc[2] = s0.z; sc[3] = s0.w; sc[4] = s1.x; sc[5] = s1.y; sc[6] = s1.z; sc[7] = s1.w; }
        float sum[8]; float f[8], z[8];
#pragma unroll
        for (int e = 0; e < 8; ++e) sum[e] = 0.f;
        for (int j = 1; j < w; ++j) { const int t = t0 - j; if (t >= 0) { unpack8(*(const GAS v4u*)(up + (size_t)t * LDU), f);
#pragma unroll
            for (int e = 0; e < 8; ++e) sum[e] += f[e]; } }
#pragma unroll 1
        for (int tb = t0; tb < t0 + RB; tb += 8) {
            v4u vv[8], vz[8], vo[8];
#pragma unroll
            for (int r = 0; r < 8; ++r) { const int t = tb + r, tl = t - w + 1;
                vv[r] = *(const GAS v4u*)(up + (size_t)t * LDU); vz[r] = *(const GAS v4u*)(up + (size_t)t * LDU + PW);
                vo[r] = *(const GAS v4u*)(up + (size_t)(tl >= 0 ? tl : 0) * LDU); }
#pragma unroll
            for (int r = 0; r < 8; ++r) { const int t = tb + r, tl = t - w + 1;
                unpack8(vv[r], f); unpack8(vz[r], z);
                const float rc = 1.0f / (float)((t + 1 < w) ? (t + 1) : w);
                float o[8];
#pragma unroll
                for (int e = 0; e < 8; ++e) { sum[e] += f[e]; o[e] = (sum[e] * rc - f[e]) * sc[e] * pg8::silu_f(z[e]); }
                v4u ov; ov.x = pk2(o[0], o[1]); ov.y = pk2(o[2], o[3]); ov.z = pk2(o[4], o[5]); ov.w = pk2(o[6], o[7]);
                *(GAS v4u*)(pp + (size_t)t * P8K) = ov;
                if (tl >= 0) { unpack8(vo[r], f);
#pragma unroll
                    for (int e = 0; e < 8; ++e) sum[e] -= f[e]; } }
        }
    }
}
__device__ __forceinline__ void p9_combine(Frame& F, const Args& a) {
    float d1 = 0.f, d2 = 0.f;
    for (int i = F.lane; i < DH; i += 64) { d1 += a.b_lam[i] * a.b_lam[DH + i]; d2 += a.b_lam[2 * DH + i] * a.b_lam[3 * DH + i]; }
    d1 = wave_sum(d1); d2 = wave_sum(d2);
    const float lam = expf(d1) - expf(d2) + LAM_INIT;
    const bf16* OC = (const bf16*)(a.ws + WS_OC); const bf16* Z = (const bf16*)(a.ws + WS_Z); bf16* YB = (bf16*)(a.ws + WS_YB);
    const int gw = F.vcu * NWAVES + F.wave, NGW = F.G * NWAVES;
    float g8[8];
    { const float* gp = a.b_subln_g + 8 * (F.lane & 31);
#pragma unroll
      for (int e = 0; e < 8; ++e) g8[e] = gp[e] * (1.0f - LAM_INIT); }
    for (int m = gw; m < S_; m += NGW) {
        const GAS v4u* o0p = (const GAS v4u*)(OC + (size_t)m * (2 * AW)) + F.lane; const GAS v4u* o1p = (const GAS v4u*)(OC + (size_t)m * (2 * AW) + AW) + F.lane;
        const GAS v4u* zp = (const GAS v4u*)(Z + (size_t)m * P4K) + F.lane; GAS v4u* yp = (GAS v4u*)(YB + (size_t)m * P4K) + F.lane;
#pragma unroll 2
        for (int j = 0; j < 8; ++j) {
            float f0[8], f1[8], fz[8], o[8];
            unpack8(o0p[64 * j], f0); unpack8(o1p[64 * j], f1); unpack8(zp[64 * j], fz);
            float ss = 0.f;
#pragma unroll
            for (int e = 0; e < 8; ++e) { o[e] = f0[e] - lam * f1[e]; ss += o[e] * o[e]; }
            const float rstd = 1.0f / sqrtf(half_sum(ss) * (1.f / 256.f) + EPS);
#pragma unroll
            for (int e = 0; e < 8; ++e) o[e] = o[e] * rstd * g8[e] * pg8::silu_f(fz[e]);
            v4u ov; ov.x = pk2(o[0], o[1]); ov.y = pk2(o[2], o[3]); ov.z = pk2(o[4], o[5]); ov.w = pk2(o[6], o[7]);
            yp[64 * j] = ov;
        }
    }
}
__device__ __forceinline__ void p11_final(Frame& F, const Args& a) {
    const int gw = F.vcu * NWAVES + F.wave, NGW = F.G * NWAVES;
    for (int m = gw; m < S_; m += NGW) {
        GAS f32x4* xr = (GAS f32x4*)(a.out + (size_t)m * DM) + F.lane; const GAS f32x4* gp = (const GAS f32x4*)a.final_g + F.lane;
        f32x4 v[16]; float s = 0.f;
#pragma unroll
        for (int j = 0; j < 16; ++j) { v[j] = xr[64 * j]; s += (v[j].x * v[j].x + v[j].y * v[j].y) + (v[j].z * v[j].z + v[j].w * v[j].w); }
        const float rstd = 1.0f / sqrtf(wave_sum(s) * (1.f / DM) + EPS);
#pragma unroll
        for (int j = 0; j < 16; ++j) xr[64 * j] = v[j] * rstd * gp[64 * j];
    }
}

__global__ void __launch_bounds__(NWAVES * 64, 2) yoco_fwd(Args args) {
    extern __shared__ __attribute__((aligned(16))) unsigned char lds[];
    Frame F;
    F.lds = (LAS unsigned char*)lds;
    F.MISC = (volatile LAS unsigned*)(F.lds + MISC_OFF);
    F.tid = threadIdx.x; F.lane = F.tid & 63; F.wave = __builtin_amdgcn_readfirstlane(F.tid >> 6);
    F.G = gridDim.x; { const int bx = blockIdx.x; F.vcu = (F.G % 8 == 0) ? (bx % 8) * (F.G / 8) + bx / 8 : bx; }
    unsigned char* ws = args.ws;
    F.ctl = (gu32*)(ws + WS_CTL);
    for (int u = F.tid; u < (LDS_BYTES - LDSCTL_OFF) / 4; u += NWAVES * 64) ((LAS unsigned*)(F.lds + LDSCTL_OFF))[u] = 0u;
    __syncthreads();
    XcdBarrier bar; bar.bar = (unsigned*)(F.ctl + CW_BAR); bar.x = 0; bar.st = nullptr;
    if (N_LAUNCHES == 1) bar = xcd_barrier_post((unsigned*)(F.ctl + CW_BAR), F.MISC + 8);
#define GRID_BAR() do { if (N_LAUNCHES == 1) xcd_barrier(bar); } while (0)
    const int lo = args.ph_lo, hi = args.ph_hi;
#define IN(k) (lo <= (k) && (k) < hi)
#define BOTH(k) (IN(k) && IN((k) + 1))
    const float* mall = (const float*)(ws + WS_ADA);
#ifdef CLOCK_PROBE
    unsigned long long ck_t0 = 0, ck_r0 = 0, ck_t1 = 1, ck_r1 = 1;
#define CK_BEGIN(k) do { if (CLOCK_PROBE == (k)) { ck_t0 = __builtin_amdgcn_s_memtime(); ck_r0 = __builtin_amdgcn_s_memrealtime(); } } while (0)
#define CK_END(k) do { if (CLOCK_PROBE == (k)) { ck_t1 = __builtin_amdgcn_s_memtime(); ck_r1 = __builtin_amdgcn_s_memrealtime(); } } while (0)
#else
#define CK_BEGIN(k) do {} while (0)
#define CK_END(k) do {} while (0)
#endif

    if (IN(0)) { p0_ada(F, args); p0_rope(F, args); p0_convert(F, args);
        if (PROBE_DUP == 0) { __syncthreads(); p0_ada(F, args); p0_rope(F, args); p0_convert(F, args); }
        if (BOTH(0)) GRID_BAR(); }

    if (IN(1)) {
        LAS float* tab = (LAS float*)(F.lds + RING_OFF);
        for (int c = F.tid; c < DM; c += NWAVES * 64) { tab[c] = args.a_norm_g[c] * (1.0f + mall[DM + c]); tab[DM + c] = mall[c]; }
        __syncthreads();
        norm_mod_rows<1>(F, args.x, (bf16*)(ws + WS_HN), nullptr, tab);
        if (PROBE_DUP == 1) norm_mod_rows<1>(F, args.x, (bf16*)(ws + WS_HN), nullptr, tab);
        __syncthreads();
        { pg8::Gemm g{(const pg8::bf16_t*)(ws + WS_W_GRP), (const pg8::bf16_t*)(ws + WS_W_INU), PW, DM, PG, P2K, P8K, 1 << 20, 0, 8, (long)PG * 2};
          pg8::StaticOrder S; S.init(PW, DM, F.G, (int)blockIdx.x);
          pg8::EpiBf16 E{(pg8::bf16_t*)(ws + WS_W_IN), P4K};
          pg8::gemm_phase<pg8::EpiBf16, pg8::StaticOrder, true, true>(F.lds + RING_OFF, g, S, E); }
        if (BOTH(1)) GRID_BAR();
    }
    if (IN(2)) {
        pg8::Gemm g{(const pg8::bf16_t*)(ws + WS_HN), (const pg8::bf16_t*)(ws + WS_W_IN), S_, 2 * PW, DM, P4K, P4K, 1 << 20, 0, 1 << 20, 0};
        pg8::StaticOrder S; S.init(S_, 2 * PW, F.G, (int)blockIdx.x);
        pg8::EpiBf16 E{(pg8::bf16_t*)(ws + WS_UZ), 2 * PW};
        CK_BEGIN(2);
        pg8::gemm_phase<pg8::EpiBf16, pg8::StaticOrder, true, true>(F.lds + RING_OFF, g, S, E);
        CK_END(2);
        if (PROBE_DUP == 2) { __syncthreads(); pg8::gemm_phase<pg8::EpiBf16, pg8::StaticOrder, true, true>(F.lds + RING_OFF, g, S, E); }
        if (PROBE_DUP == 202) { __syncthreads(); pg8::EpiNull EN; pg8::SameTileOrder S2; S2.init(S_, 2 * PW, F.G, (int)blockIdx.x); pg8::gemm_phase<pg8::EpiNull, pg8::SameTileOrder, true, true>(F.lds + RING_OFF, g, S2, EN); }
        if (PROBE_DUP == 102) { __syncthreads(); pg8::EpiNull EN; pg8::gemm_phase<pg8::EpiNull, pg8::StaticOrder, true, true>(F.lds + RING_OFF, g, S, EN); }
        if (BOTH(2)) GRID_BAR();
    }
    if (IN(3)) { p3_pool(F, args); if (PROBE_DUP == 3) p3_pool(F, args); if (BOTH(3)) GRID_BAR(); }
    if (IN(5)) {
        pg8::Gemm g{(const pg8::bf16_t*)(ws + WS_Y), (const pg8::bf16_t*)(ws + WS_W_OUTA), S_, DM, PW, P8K, P8K, 1 << 20, 0, 1 << 20, 0};
        pg8::StaticOrder S; S.init(S_, DM, F.G, (int)blockIdx.x);
        pg8::EpiResid E{args.x, (float*)(ws + WS_H1), DM, mall + 2 * DM};
        pg8::gemm_phase<pg8::EpiResid, pg8::StaticOrder, true, true>(F.lds + RING_OFF, g, S, E);
        if (BOTH(5)) GRID_BAR();
    }
    if (IN(6)) {
        LAS float* tab = (LAS float*)(F.lds + RING_OFF);
        const float* mkv = mall + 12288; const float* mb = mall + 20480;
        for (int c = F.tid; c < DM; c += NWAVES * 64) {
            tab[c] = args.kv_norm_g[c] * (1.0f + mkv[DM + c]); tab[DM + c] = mkv[c];
            tab[2 * DM + c] = args.b_norm_g[c] * (1.0f + mb[DM + c]); tab[3 * DM + c] = mb[c]; }
        __syncthreads();
        norm_mod_rows<2>(F, (const float*)(ws + WS_H1), (bf16*)(ws + WS_KVN), (bf16*)(ws + WS_HNB), tab);
        if (PROBE_DUP == 6) norm_mod_rows<2>(F, (const float*)(ws + WS_H1), (bf16*)(ws + WS_KVN), (bf16*)(ws + WS_HNB), tab);
        if (BOTH(6)) GRID_BAR();
    }
    if (IN(7)) {
        pg8::Gemm g{(const pg8::bf16_t*)(ws + WS_KVN), (const pg8::bf16_t*)(ws + WS_W_KVQG), S_, 4 * AW, DM, P4K, P4K, 32, (long)(WS_HNB - WS_KVN), 1 << 20, 0};
        pg8::StaticOrder S; S.init(S_, 4 * AW, F.G, (int)blockIdx.x);
        pg8::EpiKVQZ E{(pg8::bf16_t*)(ws + WS_K), (size_t)(WS_V - WS_K) / 2, P4K, S_, (const float*)(ws + WS_COS), (const float*)(ws + WS_SIN), atty::QSCALE};
        pg8::gemm_phase<pg8::EpiKVQZ, pg8::StaticOrder, true, true>(F.lds + RING_OFF, g, S, E);
        if (BOTH(7)) GRID_BAR();
    }
    if (IN(8)) {
        static_assert(atty::LDS_END <= LDSCTL_OFF && atty::LDZ == P4K, "attention LDS / pitches");
        const atty::bf16* Q = (const atty::bf16*)(ws + WS_Q); const atty::bf16* Kt = (const atty::bf16*)(ws + WS_K); const atty::bf16* V = (const atty::bf16*)(ws + WS_V); atty::bf16* OC = (atty::bf16*)(ws + WS_OC);
        const atty::bf16* Zt = (const atty::bf16*)(ws + WS_Z); atty::bf16* YB = (atty::bf16*)(ws + WS_YB);
        float lam;
        { float d1 = 0.f, d2 = 0.f;
          for (int i = F.lane; i < DH; i += 64) { d1 += args.b_lam[i] * args.b_lam[DH + i]; d2 += args.b_lam[2 * DH + i] * args.b_lam[3 * DH + i]; }
          d1 = wave_sum(d1); d2 = wave_sum(d2); lam = expf(d1) - expf(d2) + LAM_INIT; }
        const int ncombo = 16 * 32;
        CK_BEGIN(8);
#pragma unroll 1
        for (int pi = F.vcu; pi < ncombo; pi += F.G) {
            const int h = pi >> 5, p = pi & 31;
#pragma unroll 1
            for (int s = 0; s < 4; ++s) {
                const int c = s & 1, qb = (s & 2) ? p : 63 - p, q0 = qb * atty::UROWS, hh = 2 * h + c;
                atty::attn_unit<0>(Q + ((size_t)hh * S_ + q0) * DH, Kt + (size_t)hh * S_ * DH, V + (size_t)h * S_ * 256, OC + (size_t)q0 * AW + h * 256, c,
                                   Zt + (size_t)q0 * P4K + h * 256, YB + (size_t)q0 * P4K + h * 256, lam, args.b_subln_g, 1.0f - LAM_INIT,
                                   2 * qb + 2, 2 * qb + ((F.wave & 3) >> 1), F.lds + RING_OFF);
            }
        }
        CK_END(8);
        if (PROBE_DUP >= 800 && PROBE_DUP < 928) {
            atty::bf16* OD = (atty::bf16*)(ws + WS_END);
#pragma unroll 1
            for (int pi = F.vcu; pi < ncombo; pi += F.G) {
                const int h = pi >> 5, p = pi & 31;
#pragma unroll 1
                for (int s = 0; s < 4; ++s) {
                    const int c = s & 1, qb = (s & 2) ? p : 63 - p, q0 = qb * atty::UROWS, hh = 2 * h + c;
                    atty::attn_unit<(PROBE_DUP >= 800 && PROBE_DUP < 928) ? PROBE_DUP - 800 : 0>(Q + ((size_t)hh * S_ + q0) * DH, Kt + (size_t)hh * S_ * DH, V + (size_t)h * S_ * 256, OD + (size_t)q0 * AW + h * 256, 0,
                                       Zt, OD, lam, args.b_subln_g, 1.0f, 2 * qb + 2, 2 * qb + ((F.wave & 3) >> 1), F.lds + RING_OFF);
                }
            }
        }
        __syncthreads();
        if (BOTH(8)) GRID_BAR();
    }
    if (IN(10)) {
        pg8::Gemm g{(const pg8::bf16_t*)(ws + WS_YB), (const pg8::bf16_t*)(ws + WS_W_OUTB), S_, DM, AW, P4K, P4K, 1 << 20, 0, 1 << 20, 0};
        pg8::StaticOrder S; S.init(S_, DM, F.G, (int)blockIdx.x);
        pg8::EpiResid E{(const float*)(ws + WS_H1), args.out, DM, mall + 20480 + 2 * DM};
        pg8::gemm_phase<pg8::EpiResid, pg8::StaticOrder, true, true>(F.lds + RING_OFF, g, S, E);
        if (BOTH(10)) GRID_BAR();
    }
    if (IN(11)) { p11_final(F, args); }
#ifdef CLOCK_PROBE
    __syncthreads();
    if (blockIdx.x == 0 && F.tid == 0) { VM_WAIT(); args.out[0] = 100.0f * rintf((float)((double)(ck_t1 - ck_t0) / (double)(ck_r1 - ck_r0))); }
#endif
#undef IN
#undef BOTH
#undef GRID_BAR
}

extern "C" void kernel_launch(void* const* d_in, const int* in_sizes, int n_in, void* d_out, int out_size, void* d_ws, size_t ws_size, hipStream_t stream) {
    static int grid = 0;
    if (grid == 0) {
        if (n_in != 22 || in_sizes[0] != S_ * DM || out_size != S_ * DM || ws_size < WS_END) {
            fprintf(stderr, "kernel_launch: shape mismatch: n_in %d in0 %d out %d ws %zu (need %zu)\n", n_in, n_in > 0 ? in_sizes[0] : -1, out_size, ws_size, (size_t)WS_END); grid = -1; return; }
        int dev = 0, cus = 0, per_cu = 0;
        if (hipGetDevice(&dev) != hipSuccess || hipDeviceGetAttribute(&cus, hipDeviceAttributeMultiprocessorCount, dev) != hipSuccess) { fprintf(stderr, "kernel_launch: device query failed\n"); grid = -1; return; }
        if (hipFuncSetAttribute((const void*)yoco_fwd, hipFuncAttributeMaxDynamicSharedMemorySize, LDS_BYTES) != hipSuccess) { fprintf(stderr, "kernel_launch: hipFuncSetAttribute failed\n"); grid = -1; return; }
        if (hipOccupancyMaxActiveBlocksPerMultiprocessor(&per_cu, (const void*)yoco_fwd, NWAVES * 64, LDS_BYTES) != hipSuccess || per_cu < 1)
            fprintf(stderr, "kernel_launch: occupancy query reports %d workgroups per CU\n", per_cu);
        (void)hipGetLastError();
        grid = cus;
    }
    if (grid < 0) return;
    if (hipMemsetAsync((char*)d_ws + WS_CTL, 0, CTL_ZERO_BYTES, stream) != hipSuccess) { fprintf(stderr, "kernel_launch: memset failed\n"); return; }
    Args a{};
    a.x = (const float*)d_in[0]; a.c = (const float*)d_in[1]; a.pos = (const int*)d_in[2];
    a.a_norm_g = (const float*)d_in[3]; a.a_ada_w = (const float*)d_in[4]; a.a_ada_b = (const float*)d_in[5]; a.a_w_in = (const float*)d_in[6]; a.a_w_group = (const float*)d_in[7];
    a.a_scale = (const float*)d_in[8]; a.a_w_out = (const float*)d_in[9];
    a.kv_norm_g = (const float*)d_in[10]; a.kv_ada_w = (const float*)d_in[11]; a.kv_ada_b = (const float*)d_in[12]; a.w_kv = (const float*)d_in[13];
    a.b_norm_g = (const float*)d_in[14]; a.b_ada_w = (const float*)d_in[15]; a.b_ada_b = (const float*)d_in[16]; a.b_w_qg = (const float*)d_in[17]; a.b_lam = (const float*)d_in[18];
    a.b_subln_g = (const float*)d_in[19]; a.b_w_out = (const float*)d_in[20]; a.final_g = (const float*)d_in[21];
    a.out = (float*)d_out; a.ws = (unsigned char*)d_ws;
    for (int li = 0; li < N_LAUNCHES; ++li) {
        a.ph_lo = (N_LAUNCHES == 1) ? 0 : li; a.ph_hi = (N_LAUNCHES == 1) ? N_PHASES : li + 1; a.li = li; a.pad = 0;
        hipLaunchKernelGGL(yoco_fwd, dim3(grid), dim3(NWAVES * 64), LDS_BYTES, stream, a);
        const hipError_t le = hipPeekAtLastError();
        if (le != hipSuccess) { fprintf(stderr, "kernel_launch: launch %d failed: %s\n", li, hipGetErrorName(le)); break; }
    }
}
```

```cpp
#include <hip/hip_runtime.h>
#include <hip/hip_bf16.h>
#include <cstdio>
#include <cstdint>
#include <cmath>

#ifndef MK_N_LAUNCHES
#define MK_N_LAUNCHES 1
#endif
constexpr int N_PHASES = 12;
#ifndef PROBE_DUP
#define PROBE_DUP -1
#endif
constexpr int N_LAUNCHES = MK_N_LAUNCHES;

namespace pg8 {
#define PG8_LAS __attribute__((address_space(3)))
typedef unsigned short bf16_t;
typedef short bf16x8 __attribute__((ext_vector_type(8)));
typedef float f32x4 __attribute__((ext_vector_type(4)));
typedef float f32x2 __attribute__((ext_vector_type(2)));
typedef unsigned u32x4 __attribute__((ext_vector_type(4)));
constexpr int BM = 256, BK = 64, HALF = 128, HTB = HALF * BK * 2, STAGE_BYTES = 8 * HTB, NXCD = 8, WGM = 8;

__host__ __device__ __forceinline__ int lds_byte(int r, int c) { const int st = (r >> 4) * 2 + (c >> 5), rr = r & 15, cc = c & 31, ob = rr * 64 + cc * 2; return st * 1024 + (ob ^ (((ob >> 9) & 1) << 5)); }
__host__ __device__ __forceinline__ void stage_rc(int b, int& R, int& C) { const int st = b / 1024, sb = b % 1024, swz = sb ^ (((sb >> 9) & 1) << 5); R = (st >> 1) * 16 + swz / 64; C = (st & 1) * 32 + (swz % 64) / 2; }
__host__ __device__ __forceinline__ int perm32(int rho) { const int n = rho >> 4, i = rho & 15; return 8 * (i >> 2) + 4 * n + (i & 3); }

struct Unit { int pm, pn; };
struct Gemm { const bf16_t* A; const bf16_t* Bt; int M, N, K, lda, ldb, adiv; long astride; int bdiv; long bstride; };

struct StaticOrder {
    int nM, nN, nwg, G, c;
    __host__ __device__ void init(int M, int N, int G_, int c_) { nM = M / BM; nN = N / BM; nwg = nM * nN; G = G_; c = c_; }
    __host__ __device__ bool next(int i, Unit& u) const {
        const long L = (long)i * G + c; if (L >= nwg) return false;
        int wgid = (int)L; { const int q = nwg / NXCD, r = nwg % NXCD, xcd = wgid % NXCD, off = wgid / NXCD; wgid = (xcd < r ? xcd * (q + 1) : r * (q + 1) + (xcd - r) * q) + off; }
        const int nig = WGM * nN, gid = wgid / nig, fm = gid * WGM, gsz = (nM - fm) < WGM ? (nM - fm) : WGM;
        u.pm = fm + ((wgid % nig) % gsz); u.pn = (wgid % nig) / gsz; return true;
    }
    __device__ __forceinline__ void a_ready(const Unit&) const {}
    __device__ __forceinline__ void done(const Unit&) const {}
};

struct SameTileOrder : StaticOrder {
    __host__ __device__ bool next(int i, Unit& u) const { if (!StaticOrder::next(i, u)) return false; u.pm = 0; u.pn = 0; return true; }
};
__device__ __forceinline__ unsigned cvt_pk_bf16(float lo, float hi) { unsigned r; asm volatile("v_cvt_pk_bf16_f32 %0, %1, %2" : "=v"(r) : "v"(lo), "v"(hi)); return r; }
__device__ __forceinline__ float bf_lo(unsigned u) { return __uint_as_float(u << 16); }
__device__ __forceinline__ float bf_hi(unsigned u) { return __uint_as_float(u & 0xffff0000u); }
__device__ __forceinline__ float silu_f(float z) { return z * __builtin_amdgcn_rcpf(1.0f + __builtin_amdgcn_exp2f(-1.4426950408889634f * z)); }


struct EpiBf16 {
    static constexpr bool PERM = true;
    bf16_t* O; int ldc;
    __device__ __forceinline__ void operator()(const f32x4 (&acc)[2][2][4][2], const Unit& u, int wr, int wc, int fr, int fq) const {
        const int row0 = u.pm * BM + wr * 64 + fr, col0 = u.pn * BM + wc * 32 + 8 * fq;
#pragma unroll
        for (int ai = 0; ai < 2; ++ai)
#pragma unroll
            for (int m = 0; m < 4; ++m) { bf16_t* rowp = O + (size_t)(row0 + ai * HALF + m * 16) * ldc + col0;
#pragma unroll
                for (int bj = 0; bj < 2; ++bj) { const f32x4 v0 = acc[ai][bj][m][0], v1 = acc[ai][bj][m][1];
                    u32x4 w; w.x = cvt_pk_bf16(v0[0], v0[1]); w.y = cvt_pk_bf16(v0[2], v0[3]); w.z = cvt_pk_bf16(v1[0], v1[1]); w.w = cvt_pk_bf16(v1[2], v1[3]);
                    *(u32x4*)(rowp + bj * HALF) = w; } }
    }
};
struct EpiNull {
    static constexpr bool PERM = true;
    __device__ __forceinline__ void operator()(const f32x4 (&acc)[2][2][4][2], const Unit&, int, int, int, int) const {
#pragma unroll
        for (int ai = 0; ai < 2; ++ai)
#pragma unroll
            for (int bj = 0; bj < 2; ++bj)
#pragma unroll
                for (int m = 0; m < 4; ++m)
#pragma unroll
                    for (int n = 0; n < 2; ++n) { f32x4 v = acc[ai][bj][m][n]; asm volatile("" :: "v"(v)); }
    }
};
struct EpiPoolY {
    static constexpr bool PERM = true;
    bf16_t* O; int ldc; const float* cscale; const bf16_t* Z; int ldz;
    __device__ __forceinline__ void operator()(const f32x4 (&acc)[2][2][4][2], const Unit& u, int wr, int wc, int fr, int fq) const {
        const int row0 = u.pm * BM + wr * 64 + fr, col0 = u.pn * BM + wc * 32 + 8 * fq;
        f32x4 sv[2][2];
#pragma unroll
        for (int bj = 0; bj < 2; ++bj)
#pragma unroll
            for (int n = 0; n < 2; ++n) sv[bj][n] = *(const f32x4*)(cscale + col0 + bj * HALF + 4 * n);
#pragma unroll
        for (int ai = 0; ai < 2; ++ai)
#pragma unroll
            for (int m = 0; m < 4; ++m) { const size_t r = (size_t)(row0 + ai * HALF + m * 16); bf16_t* rowp = O + r * ldc + col0; const bf16_t* zp = Z + r * ldz + col0;
#pragma unroll
                for (int bj = 0; bj < 2; ++bj) { const u32x4 zz = *(const u32x4*)(zp + bj * HALF);
                    const f32x4 v0 = acc[ai][bj][m][0] * sv[bj][0], v1 = acc[ai][bj][m][1] * sv[bj][1];
                    u32x4 w;
                    w.x = cvt_pk_bf16(v0[0] * silu_f(bf_lo(zz.x)), v0[1] * silu_f(bf_hi(zz.x)));
                    w.y = cvt_pk_bf16(v0[2] * silu_f(bf_lo(zz.y)), v0[3] * silu_f(bf_hi(zz.y)));
                    w.z = cvt_pk_bf16(v1[0] * silu_f(bf_lo(zz.z)), v1[1] * silu_f(bf_hi(zz.z)));
                    w.w = cvt_pk_bf16(v1[2] * silu_f(bf_lo(zz.w)), v1[3] * silu_f(bf_hi(zz.w)));
                    *(u32x4*)(rowp + bj * HALF) = w; } }
    }
};
struct EpiResid {
    static constexpr bool PERM = false;
    const float* base; float* out; int ldc; const float* gate;
    __device__ __forceinline__ void operator()(const f32x4 (&acc)[2][2][4][2], const Unit& u, int wr, int wc, int fr, int fq) const {
        const int row0 = u.pm * BM + wr * 64 + fr, col0 = u.pn * BM + wc * 32 + 4 * fq;
        f32x4 gv[2][2];
#pragma unroll
        for (int bj = 0; bj < 2; ++bj)
#pragma unroll
            for (int n = 0; n < 2; ++n) gv[bj][n] = *(const f32x4*)(gate + col0 + bj * HALF + n * 16);
#pragma unroll
        for (int ai = 0; ai < 2; ++ai)
#pragma unroll
            for (int m = 0; m < 4; ++m) { const size_t off = (size_t)(row0 + ai * HALF + m * 16) * ldc + col0;
#pragma unroll
                for (int bj = 0; bj < 2; ++bj)
#pragma unroll
                    for (int n = 0; n < 2; ++n) { const f32x4 b = *(const f32x4*)(base + off + bj * HALF + n * 16);
                        *(f32x4*)(out + off + bj * HALF + n * 16) = b + gv[bj][n] * acc[ai][bj][m][n]; } }
    }
};
struct EpiKVQZ {
    static constexpr bool PERM = true;
    bf16_t* O; size_t tstride; int ldz; int S; const float* cs; const float* sn; float qscale;
    __device__ __forceinline__ void operator()(const f32x4 (&acc)[2][2][4][2], const Unit& u, int wr, int wc, int fr, int fq) const {
        const int t = u.pn >> 4, pt = u.pn & 15; const bool rot = (t == 0) || (t == 2);
        const int row0 = u.pm * BM + wr * 64 + fr, cw = wc * 32 + 8 * fq, i0 = wc * 16 + 4 * fq;
        bf16_t* base = O + (size_t)t * tstride;
#pragma unroll
        for (int ai = 0; ai < 2; ++ai)
#pragma unroll
            for (int m = 0; m < 4; ++m) { const int row = row0 + ai * HALF + m * 16;
                f32x4 c4 = (f32x4){1.f, 1.f, 1.f, 1.f}, s4 = (f32x4){0.f, 0.f, 0.f, 0.f};
                if (rot) { c4 = *(const f32x4*)(cs + (size_t)row * 64 + i0); s4 = *(const f32x4*)(sn + (size_t)row * 64 + i0); }
                if (t == 2) { c4 = c4 * qscale; s4 = s4 * qscale; }
#pragma unroll
                for (int bj = 0; bj < 2; ++bj) { const f32x4 v0 = acc[ai][bj][m][0], v1 = acc[ai][bj][m][1];
                    u32x4 w;
                    w.x = cvt_pk_bf16(v0[0] * c4[0] - v0[1] * s4[0], v0[1] * c4[0] + v0[0] * s4[0]);
                    w.y = cvt_pk_bf16(v0[2] * c4[1] - v0[3] * s4[1], v0[3] * c4[1] + v0[2] * s4[1]);
                    w.z = cvt_pk_bf16(v1[0] * c4[2] - v1[1] * s4[2], v1[1] * c4[2] + v1[0] * s4[2]);
                    w.w = cvt_pk_bf16(v1[2] * c4[3] - v1[3] * s4[3], v1[3] * c4[3] + v1[2] * s4[3]);
                    bf16_t* dst;
                    if (t == 3) dst = base + (size_t)row * ldz + pt * BM + bj * HALF + cw;
                    else if (t == 1) dst = base + ((size_t)pt * S + row) * 256 + bj * HALF + cw;
                    else dst = base + ((size_t)(pt * 2 + bj) * S + row) * 128 + cw;
                    *(u32x4*)dst = w; } }
    }
};

template <class Epi, class Sched, bool ALIGN_EPI = false, bool SP2 = false>
__device__ __forceinline__ void gemm_phase(PG8_LAS unsigned char* lds, const Gemm g, const Sched& S, const Epi& E) {
    const int tid = threadIdx.x, wid = __builtin_amdgcn_readfirstlane(tid >> 6), lane = tid & 63, wr = wid >> 2, wc = wid & 3, fr = lane & 15, fq = lane >> 4;
    const int K = g.K, nt = K / BK;
    unsigned voffA[2], voffB[2];
#pragma unroll
    for (int i = 0; i < 2; ++i) { int R, C; stage_rc(tid * 16 + i * 8192, R, C); const int Rb = Epi::PERM ? ((R & ~31) + perm32(R & 31)) : R;
        voffA[i] = (unsigned)(R * g.lda + C) * 2u; voffB[i] = (unsigned)(Rb * g.ldb + C) * 2u; }
    const size_t kstep = (size_t)(BK * 2);
    const size_t hstepA = (size_t)HALF * g.lda * 2, hstepB = (size_t)HALF * g.ldb * 2;
    const unsigned ldsw = (unsigned)wid * 1024u;
    const int aoff = lds_byte(wr * 64 + fr, fq * 8), boff = lds_byte(wc * 32 + fr, fq * 8);
#define PG8_UA(u) ((const char*)g.A + (size_t)(u).pm * 2 * hstepA + (size_t)((u).pn / g.adiv) * (size_t)g.astride)
#define PG8_UB(u) ((const char*)g.Bt + (size_t)(u).pn * 2 * hstepB + (size_t)((u).pm / g.bdiv) * (size_t)g.bstride)
#define PG8_SA(b, h) (((b) * 2 + (h)) * HTB)
#define PG8_SB(b, h) ((4 + (b) * 2 + (h)) * HTB)
#define PG8_STAGE(bufoff, gbase, voff) do { _Pragma("unroll") for (int _i = 0; _i < 2; ++_i) \
        __builtin_amdgcn_global_load_lds((const unsigned*)((const char*)(gbase) + (voff)[_i]), (PG8_LAS unsigned*)(lds + (bufoff) + ldsw + _i * 8192), 16, 0, 0); } while (0)
#define PG8_LDA(dst, b, h) do { _Pragma("unroll") for (int m = 0; m < 4; ++m) _Pragma("unroll") for (int k = 0; k < 2; ++k) dst[m][k] = *(const PG8_LAS bf16x8*)(lds + PG8_SA(b, h) + aoff + m * 2048 + k * 1024); } while (0)
#define PG8_LDB(dst, b, h) do { _Pragma("unroll") for (int n = 0; n < 2; ++n) _Pragma("unroll") for (int k = 0; k < 2; ++k) dst[n][k] = *(const PG8_LAS bf16x8*)(lds + PG8_SB(b, h) + boff + n * 2048 + k * 1024); } while (0)
#define PG8_MMA(ai, bj, At, Bt) do { __builtin_amdgcn_s_setprio(1); _Pragma("unroll") for (int m = 0; m < 4; ++m) _Pragma("unroll") for (int n = 0; n < 2; ++n) _Pragma("unroll") for (int k = 0; k < 2; ++k) \
        acc[ai][bj][m][n] = __builtin_amdgcn_mfma_f32_16x16x32_bf16(Bt[n][k], At[m][k], acc[ai][bj][m][n], 0, 0, 0); __builtin_amdgcn_s_setprio(0); } while (0)
#define PG8_WAIT_V(n) asm volatile("s_waitcnt vmcnt(" #n ")" ::: "memory")
#define PG8_WAIT_L(n) asm volatile("s_waitcnt lgkmcnt(" #n ")" ::: "memory")
#define PG8_BAR __builtin_amdgcn_s_barrier()
#define PG8_SCHED __builtin_amdgcn_sched_barrier(0)
    Unit cur, nxt; int ui = 0;
    if (!S.next(0, cur)) return;
    f32x4 acc[2][2][4][2];
#pragma unroll
    for (int a = 0; a < 2; ++a)
#pragma unroll
        for (int b = 0; b < 2; ++b)
#pragma unroll
            for (int m = 0; m < 4; ++m)
#pragma unroll
                for (int n = 0; n < 2; ++n) acc[a][b][m][n] = (f32x4){0.f, 0.f, 0.f, 0.f};
    bf16x8 At[4][2], B0[2][2], B1[2][2];
    const char* cA = PG8_UA(cur); const char* cB = PG8_UB(cur);
    S.a_ready(cur);
    if constexpr (SP2) {
        PG8_STAGE(PG8_SB(0, 0), cB, voffB); PG8_STAGE(PG8_SB(0, 1), cB + hstepB, voffB); PG8_STAGE(PG8_SA(0, 0), cA, voffA); PG8_STAGE(PG8_SA(0, 1), cA + hstepA, voffA);
        if (wr == 1) PG8_BAR;
        PG8_WAIT_V(2); PG8_BAR;
        PG8_STAGE(PG8_SB(1, 0), cB + kstep, voffB); PG8_STAGE(PG8_SA(1, 0), cA + kstep, voffA); PG8_STAGE(PG8_SB(1, 1), cB + hstepB + kstep, voffB);
        PG8_WAIT_V(6); PG8_BAR;
    } else {
        PG8_STAGE(PG8_SB(0, 0), cB, voffB); PG8_STAGE(PG8_SA(0, 0), cA, voffA); PG8_STAGE(PG8_SB(0, 1), cB + hstepB, voffB); PG8_STAGE(PG8_SA(0, 1), cA + hstepA, voffA);
        if (wr == 1) PG8_BAR;
        PG8_WAIT_V(4); PG8_BAR;
        PG8_STAGE(PG8_SB(1, 0), cB + kstep, voffB); PG8_STAGE(PG8_SA(1, 0), cA + kstep, voffA); PG8_STAGE(PG8_SB(1, 1), cB + hstepB + kstep, voffB);
        PG8_WAIT_V(6); PG8_BAR;
    }
    for (;;) {
        const bool has_next = S.next(ui + 1, nxt);
        const char* nA = has_next ? PG8_UA(nxt) : cA; const char* nB = has_next ? PG8_UB(nxt) : cB;
        for (int t = 0; t < nt; t += 2) {
            const bool last = (t == nt - 2);
            const char* a1 = cA + (size_t)(t + 1) * kstep;
            const char* a2 = last ? nA : cA + (size_t)(t + 2) * kstep; const char* b2 = last ? nB : cB + (size_t)(t + 2) * kstep;
            const char* a3 = a2 + kstep; const char* b3 = b2 + kstep;
            if (last && has_next) S.a_ready(nxt);
            if constexpr (SP2) {
            PG8_LDB(B0, 0, 0); PG8_LDB(B1, 0, 1); PG8_SCHED; PG8_LDA(At, 0, 0); PG8_STAGE(PG8_SA(1, 1), a1 + hstepA, voffA);
            PG8_WAIT_V(8); PG8_WAIT_L(0); PG8_BAR; PG8_MMA(0, 0, At, B0); PG8_MMA(0, 1, At, B1); PG8_BAR; PG8_SCHED;
            PG8_LDA(At, 0, 1); PG8_STAGE(PG8_SB(0, 0), b2, voffB); PG8_STAGE(PG8_SB(0, 1), b2 + hstepB, voffB); PG8_STAGE(PG8_SA(0, 0), a2, voffA);
            PG8_WAIT_V(8); PG8_WAIT_L(0); PG8_BAR; PG8_MMA(1, 0, At, B0); PG8_MMA(1, 1, At, B1); PG8_BAR; PG8_SCHED;
            PG8_LDB(B0, 1, 0); PG8_LDB(B1, 1, 1); PG8_SCHED; PG8_LDA(At, 1, 0); PG8_STAGE(PG8_SA(0, 1), a2 + hstepA, voffA);
            PG8_WAIT_V(8); PG8_WAIT_L(0); PG8_BAR; PG8_MMA(0, 0, At, B0); PG8_MMA(0, 1, At, B1); PG8_BAR; PG8_SCHED;
            PG8_LDA(At, 1, 1); PG8_STAGE(PG8_SB(1, 0), b3, voffB); PG8_STAGE(PG8_SB(1, 1), b3 + hstepB, voffB); PG8_STAGE(PG8_SA(1, 0), a3, voffA);
            PG8_WAIT_V(8); PG8_WAIT_L(0); PG8_BAR; PG8_MMA(1, 0, At, B0); PG8_MMA(1, 1, At, B1); PG8_BAR; PG8_SCHED;
            } else {
            PG8_LDB(B0, 0, 0); PG8_SCHED; PG8_LDA(At, 0, 0); PG8_STAGE(PG8_SA(1, 1), a1 + hstepA, voffA);
            PG8_WAIT_L(8); PG8_BAR; PG8_WAIT_L(0); PG8_MMA(0, 0, At, B0); PG8_BAR; PG8_SCHED;
            PG8_LDB(B1, 0, 1); PG8_STAGE(PG8_SB(0, 0), b2, voffB);
            PG8_BAR; PG8_WAIT_L(0); PG8_MMA(0, 1, At, B1); PG8_BAR;
            PG8_LDA(At, 0, 1); PG8_STAGE(PG8_SA(0, 0), a2, voffA);
            PG8_BAR; PG8_WAIT_L(0); PG8_MMA(1, 0, At, B0); PG8_BAR; PG8_SCHED;
            PG8_STAGE(PG8_SB(0, 1), b2 + hstepB, voffB);
            PG8_WAIT_V(6); PG8_BAR; PG8_MMA(1, 1, At, B1); PG8_BAR;
            PG8_LDB(B0, 1, 0); PG8_SCHED; PG8_LDA(At, 1, 0); PG8_STAGE(PG8_SA(0, 1), a2 + hstepA, voffA);
            PG8_WAIT_L(8); PG8_BAR; PG8_WAIT_L(0); PG8_MMA(0, 0, At, B0); PG8_BAR; PG8_SCHED;
            PG8_LDB(B1, 1, 1); PG8_STAGE(PG8_SB(1, 0), b3, voffB);
            PG8_BAR; PG8_WAIT_L(0); PG8_MMA(0, 1, At, B1); PG8_BAR;
            PG8_LDA(At, 1, 1); PG8_STAGE(PG8_SA(1, 0), a3, voffA);
            PG8_BAR; PG8_WAIT_L(0); PG8_MMA(1, 0, At, B0); PG8_BAR; PG8_SCHED;
            PG8_STAGE(PG8_SB(1, 1), b3 + hstepB, voffB);
            PG8_WAIT_V(6); PG8_BAR; PG8_MMA(1, 1, At, B1); PG8_BAR;
            }
        }
        if constexpr (ALIGN_EPI) { if (wr == 0) PG8_BAR; }
        E(acc, cur, wr, wc, fr, fq); S.done(cur);
        if (!has_next) break;
#pragma unroll
        for (int a = 0; a < 2; ++a)
#pragma unroll
            for (int b = 0; b < 2; ++b)
#pragma unroll
                for (int m = 0; m < 4; ++m)
#pragma unroll
                    for (int n = 0; n < 2; ++n) acc[a][b][m][n] = (f32x4){0.f, 0.f, 0.f, 0.f};
        cur = nxt; cA = nA; cB = nB; ++ui;
        if constexpr (ALIGN_EPI) { if (wr == 1) PG8_BAR; }
    }
    PG8_WAIT_V(0);
    if constexpr (!ALIGN_EPI) { if (wr == 0) PG8_BAR; }
    PG8_BAR;
#undef PG8_UA
#undef PG8_UB
#undef PG8_SA
#undef PG8_SB
#undef PG8_STAGE
#undef PG8_LDA
#undef PG8_LDB
#undef PG8_MMA
#undef PG8_WAIT_V
#undef PG8_WAIT_L
#undef PG8_BAR
#undef PG8_SCHED
}
}

namespace atty {
using bf16 = __hip_bfloat16;
using bf16x8 = __attribute__((ext_vector_type(8))) short;
using s16x4  = __attribute__((ext_vector_type(4))) short;
using f32x16 = __attribute__((ext_vector_type(16))) float;
using u32x4  = __attribute__((ext_vector_type(4))) unsigned;
#define ATY_LAS __attribute__((address_space(3)))
constexpr int QBLK = 32, KVBLK = 64, UROWS = 128;
constexpr float SCALE = 0.088388347648318440f;
constexpr float THR = 8.f, THRL = THR * 1.4426950408889634f;
constexpr float QSCALE = SCALE * 1.4426950408889634f;
constexpr int LDQ = 128, LDK = 128, LDV = 256, LDO = 4096, LDZ = 4096 + 64;
constexpr int KBUF = 16384, VBUF = 32768, PBUF = 16384;
constexpr int LDS_K = 0, LDS_V = 2 * KBUF, LDS_P = LDS_V + 2 * VBUF, LDS_AL = LDS_P + 2 * PBUF, LDS_LI = LDS_AL + 2 * 4 * 128, LDS_END = LDS_LI + 4 * 128;
#define SBAR() __builtin_amdgcn_sched_barrier(0)
__device__ __forceinline__ int crow(int r, int hi) { return (r & 3) + 8 * (r >> 2) + 4 * hi; }
__device__ __forceinline__ unsigned cvtpk(float lo, float hi) { unsigned r; asm volatile("v_cvt_pk_bf16_f32 %0, %1, %2" : "=v"(r) : "v"(lo), "v"(hi)); return r; }
__device__ __forceinline__ unsigned rfl(unsigned v) { return (unsigned)__builtin_amdgcn_readfirstlane((int)v); }
__device__ __forceinline__ void dma16(unsigned m0v, int voff, __amdgpu_buffer_rsrc_t srd, unsigned soff) {
  unsigned keep;
  asm volatile("s_nop 4\n\ts_mov_b32 %0, m0\n\ts_mov_b32 m0, %1\n\ts_nop 0\n\tbuffer_load_dwordx4 %2, %3, %4 offen lds\n\ts_mov_b32 m0, %0"
               : "=&s"(keep) : "s"(m0v), "v"(voff), "s"(srd), "s"(soff) : "memory");
}
constexpr int v_rd_off(int d0, int ks, int half) { return d0 * 512 + ks * 4096 + half * 2048; }
__device__ __forceinline__ int v_rd_base(int lane) { return ((lane & 3) << 3) | (((lane >> 2) & 3) << 6) | (((lane >> 4) & 1) << 5) | (((lane >> 5) & 1) << 8); }
template <int OFF> __device__ __forceinline__ s16x4 tr_read(int vb) {
  s16x4 r; asm volatile("ds_read_b64_tr_b16 %0, %1 offset:%2" : "=&v"(r) : "v"(vb), "i"(OFF) : "memory"); return r;
}
template <int BASE> __device__ __forceinline__ void pv_one(f32x16& od, int vb, bf16x8 pa0, bf16x8 pa1, bf16x8 pa2, bf16x8 pa3) {
  const s16x4 l0 = tr_read<BASE + v_rd_off(0, 0, 0)>(vb), h0 = tr_read<BASE + v_rd_off(0, 0, 1)>(vb), l1 = tr_read<BASE + v_rd_off(0, 1, 0)>(vb), h1 = tr_read<BASE + v_rd_off(0, 1, 1)>(vb);
  const s16x4 l2 = tr_read<BASE + v_rd_off(0, 2, 0)>(vb), h2 = tr_read<BASE + v_rd_off(0, 2, 1)>(vb), l3 = tr_read<BASE + v_rd_off(0, 3, 0)>(vb), h3 = tr_read<BASE + v_rd_off(0, 3, 1)>(vb);
  asm volatile("s_waitcnt lgkmcnt(0)" ::: "memory"); SBAR();
#define PK(L, H) (bf16x8){L[0], L[1], L[2], L[3], H[0], H[1], H[2], H[3]}
  od = __builtin_amdgcn_mfma_f32_32x32x16_bf16(pa0, PK(l0, h0), od, 0, 0, 0);
  od = __builtin_amdgcn_mfma_f32_32x32x16_bf16(pa1, PK(l1, h1), od, 0, 0, 0);
  od = __builtin_amdgcn_mfma_f32_32x32x16_bf16(pa2, PK(l2, h2), od, 0, 0, 0);
  od = __builtin_amdgcn_mfma_f32_32x32x16_bf16(pa3, PK(l3, h3), od, 0, 0, 0);
#undef PK
}

template <int MODE>
__device__ __forceinline__ void attn_unit(const bf16* __restrict__ Qb, const bf16* __restrict__ Kh, const bf16* __restrict__ Vh, bf16* __restrict__ Ob, int cmap, const bf16* __restrict__ Zb, bf16* __restrict__ Yb,
                                          float lam, const float* __restrict__ subg, float oscale, int NT, int jw, ATY_LAS unsigned char* lds) {
  const int tid = threadIdx.x, lane = tid & 63, r32 = lane & 31, hi = lane >> 5;
  const int wid = __builtin_amdgcn_readfirstlane(tid >> 6), grp = wid & 3; const bool swave = wid < 4;
  const unsigned lds0 = (unsigned)(uintptr_t)lds;
  const __amdgpu_buffer_rsrc_t srdK = __builtin_amdgcn_make_buffer_rsrc((void*)Kh, 0, 0x7fffffff, 0x00020000), srdV = __builtin_amdgcn_make_buffer_rsrc((void*)Vh, 0, 0x7fffffff, 0x00020000);
  int kvo[2], vvo[4];
#pragma unroll
  for (int e = 0; e < 2; ++e) { const int row = 8 * wid + 4 * e + (lane >> 4), ch = (lane & 15) ^ (row & 7); kvo[e] = (row * LDK + ch * 8) * 2; }
#pragma unroll
  for (int e = 0; e < 4; ++e) { const int pj = 4 * wid + e, hv = pj >> 4, j = pj & 15, sb = 2 * j + (lane >> 5), kk = (sb >> 2) * 8 + ((lane & 31) >> 2), c = (sb & 3) * 32 + (lane & 3) * 8;
    vvo[e] = (kk * LDV + hv * 128 + c) * 2; }
#define DMA_K(t, buf) do { if (MODE & 1) break; _Pragma("unroll") for (int e_ = 0; e_ < 2; ++e_) dma16(rfl(lds0 + LDS_K + (unsigned)(buf) * KBUF + (unsigned)(2 * wid + e_) * 1024u), kvo[e_], srdK, rfl((unsigned)(t) * (KVBLK * LDK * 2))); } while (0)
#define DMA_V(t, buf) do { if (MODE & 1) break; _Pragma("unroll") for (int e_ = 0; e_ < 4; ++e_) dma16(rfl(lds0 + LDS_V + (unsigned)(buf) * VBUF + (unsigned)(4 * wid + e_) * 1024u), vvo[e_], srdV, rfl((unsigned)(t) * (KVBLK * LDV * 2))); } while (0)
#define DMA_K1(t, buf, e_) do { if (MODE & 1) break; dma16(rfl(lds0 + LDS_K + (unsigned)(buf) * KBUF + (unsigned)(2 * wid + (e_)) * 1024u), kvo[e_], srdK, rfl((unsigned)(t) * (KVBLK * LDK * 2))); } while (0)
#define DMA_V1(t, buf, e_) do { if (MODE & 1) break; dma16(rfl(lds0 + LDS_V + (unsigned)(buf) * VBUF + (unsigned)(4 * wid + (e_)) * 1024u), vvo[e_], srdV, rfl((unsigned)(t) * (KVBLK * LDV * 2))); } while (0)
#define WAITV_BAR() asm volatile("s_waitcnt vmcnt(0) lgkmcnt(0)\n\ts_barrier" ::: "memory")
  const unsigned pofs = lds0 + LDS_P + (unsigned)grp * 4096u + (unsigned)lane * 16u;
  ATY_LAS float* al_l = (ATY_LAS float*)(lds + LDS_AL) + grp * 32;
  ATY_LAS float* li_l = (ATY_LAS float*)(lds + LDS_LI) + grp * 32;
  if (swave) {
    bf16x8 qr[8];
    { const __amdgpu_buffer_rsrc_t srdQ = __builtin_amdgcn_make_buffer_rsrc((void*)Qb, 0, 0x7fffffff, 0x00020000);
      const int qoff = ((grp * QBLK + r32) * LDQ + hi * 8) * 2;
#pragma unroll
      for (int d0 = 0; d0 < 8; ++d0) qr[d0] = __builtin_bit_cast(bf16x8, __builtin_amdgcn_raw_buffer_load_b128(srdQ, qoff + d0 * 32, 0, 0)); }
    if (!(MODE & 1)) {
#pragma unroll
      for (int e = 0; e < 4; ++e) { const int row = 16 * grp + 4 * e + (lane >> 4), ch = (lane & 15) ^ (row & 7); const int ko = (row * LDK + ch * 8) * 2;
        dma16(rfl(lds0 + LDS_K + (unsigned)(4 * grp + e) * 1024u), ko, srdK, 0u);
        if (NT > 1) dma16(rfl(lds0 + LDS_K + KBUF + (unsigned)(4 * grp + e) * 1024u), ko, srdK, rfl((unsigned)(KVBLK * LDK * 2))); } }
    unsigned kp0[4];
#pragma unroll
    for (int dd = 0; dd < 4; ++dd) kp0[dd] = lds0 + LDS_K + (unsigned)(r32 * 256 + (((dd * 16 + hi * 8) * 2) ^ ((r32 & 7) << 4)));
    float m_ref = 0.f, l_reg = 0.f;
    f32x16 negm = f32x16{}, pA0 = f32x16{}, pA1 = f32x16{}, pB0 = f32x16{}, pB1 = f32x16{};
#pragma unroll
    for (int d0 = 0; d0 < 8; ++d0) asm volatile("" : "+v"(qr[d0]));
    WAITV_BAR();
    __builtin_amdgcn_s_setprio(1);
#define ATY_QK(D0, D1, t, WITH_DMA, i) do { const unsigned kofs_ = (unsigned)((t) & 1) * KBUF; D0 = negm; D1 = negm; \
        _Pragma("unroll") for (int d0 = 0; d0 < 8; ++d0) { const unsigned a_ = kp0[d0 & 3] + kofs_ + (d0 >> 2) * 128; \
          const bf16x8 b0 = *(const ATY_LAS bf16x8*)(uintptr_t)a_; const bf16x8 b1 = *(const ATY_LAS bf16x8*)(uintptr_t)(a_ + 8192); \
          D0 = __builtin_amdgcn_mfma_f32_32x32x16_bf16(b0, qr[d0], D0, 0, 0, 0); \
          D1 = __builtin_amdgcn_mfma_f32_32x32x16_bf16(b1, qr[d0], D1, 0, 0, 0); \
          if (WITH_DMA) { if (d0 == 0 && dk) DMA_K1((i) + 2, (i) & 1, 0); if (d0 == 1 && dk) DMA_K1((i) + 2, (i) & 1, 1); if (d0 >= 2 && d0 < 6 && dv) DMA_V1((i), (i) & 1, d0 - 2); } } } while (0)
#define ATY_SM(P0, P1, N0, N1, i) do { \
        if (MODE & 64) { const unsigned pdst = pofs + (unsigned)((i) & 1) * PBUF; ATY_PK4(P0, 0, 0); ATY_PK4(P0, 8, 1); ATY_PK4(P1, 0, 2); ATY_PK4(P1, 8, 3); if (hi == 0) al_l[((i) & 1) * 128 + r32] = 1.f; break; } \
        float a0 = fmaxf(P0[0], P0[1]), a1 = fmaxf(P1[0], P1[1]); \
        _Pragma("unroll") for (int r = 2; r < 16; r += 2) { a0 = fmaxf(fmaxf(a0, P0[r]), P0[r + 1]); a1 = fmaxf(fmaxf(a1, P1[r]), P1[r + 1]); } \
        float pmax = fmaxf(a0, a1); \
        { auto rr = __builtin_amdgcn_permlane32_swap(__float_as_uint(pmax), __float_as_uint(pmax), false, false); \
          pmax = fmaxf(__uint_as_float(rr[0]), __uint_as_float(rr[1])); } \
        float alpha = 1.f; \
        if (__builtin_expect((i) == 0 || __any(pmax > THRL), 0)) {          \
          const float dl = ((i) == 0) ? pmax : fmaxf(pmax, 0.f); \
          m_ref += dl; alpha = ((i) == 0) ? 1.f : __builtin_amdgcn_exp2f(-dl); \
          _Pragma("unroll") for (int r = 0; r < 16; ++r) { P0[r] -= dl; P1[r] -= dl; N0[r] -= dl; N1[r] -= dl; negm[r] = -m_ref; } } \
        _Pragma("unroll") for (int r = 0; r < 16; ++r) { P0[r] = __builtin_amdgcn_exp2f(P0[r]); P1[r] = __builtin_amdgcn_exp2f(P1[r]); } \
        float s0 = P0[0], s1 = P0[1], s2 = P1[0], s3 = P1[1]; \
        _Pragma("unroll") for (int r = 2; r < 16; r += 2) { s0 += P0[r]; s1 += P0[r + 1]; s2 += P1[r]; s3 += P1[r + 1]; } \
        float ps = (s0 + s1) + (s2 + s3); \
        { auto rr = __builtin_amdgcn_permlane32_swap(__float_as_uint(ps), __float_as_uint(ps), false, false); \
          ps = __uint_as_float(rr[0]) + __uint_as_float(rr[1]); } \
        l_reg = l_reg * alpha + ps; \
        const unsigned pdst = pofs + (unsigned)((i) & 1) * PBUF; \
        ATY_PK4(P0, 0, 0); ATY_PK4(P0, 8, 1); ATY_PK4(P1, 0, 2); ATY_PK4(P1, 8, 3); \
        if (hi == 0) al_l[((i) & 1) * 128 + r32] = alpha; } while (0)
#define ATY_PK4(P, BASE, KS) do { u32x4 w = {cvtpk(P[BASE + 0], P[BASE + 1]), cvtpk(P[BASE + 2], P[BASE + 3]), cvtpk(P[BASE + 4], P[BASE + 5]), cvtpk(P[BASE + 6], P[BASE + 7])}; \
    *(ATY_LAS u32x4*)(uintptr_t)(pdst + (KS) * 1024u) = w; } while (0)
#define ATY_DMA_PLAIN(i) do { if ((i) + 2 < NT) DMA_K((i) + 2, (i) & 1); if ((i) < NT) DMA_V((i), (i) & 1); } while (0)
#define ATY_STEP(C0, C1, N0, N1, i) do { const bool dk = ((i) + 2 < NT), dv = true; ATY_QK(N0, N1, (i) + 1, true, i); ATY_SM(C0, C1, N0, N1, i); WAITV_BAR(); } while (0)
#define ATY_TAIL(C0, C1, N0, N1, i) do { ATY_DMA_PLAIN(i); ATY_SM(C0, C1, N0, N1, i); WAITV_BAR(); } while (0)
    int i = 0;
    if (!(MODE & 6)) {
      { const bool dk = false, dv = false; ATY_QK(pA0, pA1, 0, false, 0); (void)dk; (void)dv; }
      WAITV_BAR();
#pragma unroll 1
      for (;;) {
        if (i >= jw) { ATY_TAIL(pA0, pA1, pB0, pB1, i); break; }
        ATY_STEP(pA0, pA1, pB0, pB1, i); ++i;
        if (i >= jw) { ATY_TAIL(pB0, pB1, pA0, pA1, i); break; }
        ATY_STEP(pB0, pB1, pA0, pA1, i); ++i;
      }
      ++i;
    } else WAITV_BAR();
#pragma unroll 1
    for (; i < NT; ++i) { ATY_DMA_PLAIN(i); WAITV_BAR(); }
    WAITV_BAR();
#undef ATY_DMA_PLAIN
#undef ATY_STEP
#undef ATY_TAIL
#undef ATY_QK
#undef ATY_SM
#undef ATY_PK4
    __builtin_amdgcn_s_setprio(0);
    if (hi == 0) li_l[r32] = l_reg;
    WAITV_BAR();
  } else {
    f32x16 o[8];
#pragma unroll
    for (int d = 0; d < 8; ++d) o[d] = f32x16{};
    const int vb0 = (int)(lds0 + LDS_V) + v_rd_base(lane);
    WAITV_BAR();
    WAITV_BAR();
#pragma unroll 1
    for (int i = 0; i <= NT; ++i) {
      if (i + 2 < NT) DMA_K(i + 2, i & 1);
      if (i < NT) DMA_V(i, i & 1);
      const int t = i - 1;
      if (t >= 0 && t <= jw && !(MODE & 10)) {
        const int b = t & 1;
        const int vb = vb0 + b * VBUF;
        s16x4 EXl0 = {}, EXh0 = {}, EXl1 = {}, EXh1 = {}, EYl0 = {}, EYh0 = {}, EYl1 = {}, EYh1 = {}, FXl0 = {}, FXh0 = {}, FXl1 = {}, FXh1 = {}, FYl0 = {}, FYh0 = {}, FYl1 = {}, FYh1 = {};
#define VRH(S, BX, BY, H) do { if (MODE & 32) { asm volatile("" : "+v"(S##Xl0), "+v"(S##Xh0), "+v"(S##Xl1), "+v"(S##Xh1), "+v"(S##Yl0), "+v"(S##Yh0), "+v"(S##Yl1), "+v"(S##Yh1)); break; } \
        S##Xl0 = tr_read<BX + v_rd_off(0, 2 * H, 0)>(vb); S##Xh0 = tr_read<BX + v_rd_off(0, 2 * H, 1)>(vb); S##Yl0 = tr_read<BY + v_rd_off(0, 2 * H, 0)>(vb); S##Yh0 = tr_read<BY + v_rd_off(0, 2 * H, 1)>(vb); \
        S##Xl1 = tr_read<BX + v_rd_off(0, 2 * H + 1, 0)>(vb); S##Xh1 = tr_read<BX + v_rd_off(0, 2 * H + 1, 1)>(vb); S##Yl1 = tr_read<BY + v_rd_off(0, 2 * H + 1, 0)>(vb); S##Yh1 = tr_read<BY + v_rd_off(0, 2 * H + 1, 1)>(vb); } while (0)
#define PKV(L, H) (bf16x8){L[0], L[1], L[2], L[3], H[0], H[1], H[2], H[3]}
#define VMH(S, ox, oy, PA, PB) do { ox = __builtin_amdgcn_mfma_f32_32x32x16_bf16(PA, PKV(S##Xl0, S##Xh0), ox, 0, 0, 0); oy = __builtin_amdgcn_mfma_f32_32x32x16_bf16(PA, PKV(S##Yl0, S##Yh0), oy, 0, 0, 0); \
                                   ox = __builtin_amdgcn_mfma_f32_32x32x16_bf16(PB, PKV(S##Xl1, S##Xh1), ox, 0, 0, 0); oy = __builtin_amdgcn_mfma_f32_32x32x16_bf16(PB, PKV(S##Yl1, S##Yh1), oy, 0, 0, 0); } while (0)
#define LW0() do { SBAR(); asm volatile("s_waitcnt lgkmcnt(0)" ::: "memory"); SBAR(); } while (0)
#define BLK(d) (((d) >> 2) * 16384 + ((d) & 3) * 512)
        VRH(E, BLK(0), BLK(1), 0);
        const float am = al_l[b * 128 + r32];
        const unsigned psrc = pofs + (unsigned)b * PBUF;
        const bf16x8 pa0 = *(const ATY_LAS bf16x8*)(uintptr_t)(psrc), pa1 = *(const ATY_LAS bf16x8*)(uintptr_t)(psrc + 1024u);
        const bf16x8 pa2 = *(const ATY_LAS bf16x8*)(uintptr_t)(psrc + 2048u), pa3 = *(const ATY_LAS bf16x8*)(uintptr_t)(psrc + 3072u);
        if (__any(am < 1.f)) {
          asm volatile("s_waitcnt lgkmcnt(0)" ::: "memory");
#pragma unroll
          for (int r = 0; r < 16; ++r) { const float f = al_l[b * 128 + crow(r, hi)];
#pragma unroll
            for (int d = 0; d < 8; ++d) o[d][r] *= f; } }
        LW0();
        VRH(F, BLK(0), BLK(1), 1); VMH(E, o[0], o[1], pa0, pa1); LW0();
        VRH(E, BLK(2), BLK(3), 0); VMH(F, o[0], o[1], pa2, pa3); LW0();
        VRH(F, BLK(2), BLK(3), 1); VMH(E, o[2], o[3], pa0, pa1); LW0();
        VRH(E, BLK(4), BLK(5), 0); VMH(F, o[2], o[3], pa2, pa3); LW0();
        VRH(F, BLK(4), BLK(5), 1); VMH(E, o[4], o[5], pa0, pa1); LW0();
        VRH(E, BLK(6), BLK(7), 0); VMH(F, o[4], o[5], pa2, pa3); LW0();
        VRH(F, BLK(6), BLK(7), 1); VMH(E, o[6], o[7], pa0, pa1); LW0();
        VMH(F, o[6], o[7], pa2, pa3);
#undef VRH
#undef VMH
#undef BLK
#undef PKV
#undef LW0
      }
      WAITV_BAR();
    }
    WAITV_BAR();
    float rli[16];
#pragma unroll
    for (int r = 0; r < 16; ++r) rli[r] = __builtin_amdgcn_rcpf(li_l[crow(r, hi)]);
    { ATY_LAS unsigned short* stg = (ATY_LAS unsigned short*)(lds + LDS_V + grp * 16384);
#pragma unroll
      for (int r = 0; r < 16; ++r) { const int orow = crow(r, hi);
#pragma unroll
        for (int d = 0; d < 8; ++d) { const float v = o[d][r] * rli[r]; stg[orow * 256 + d * 32 + r32] = (unsigned short)(cvtpk(v, v) & 0xffffu); } }
      asm volatile("s_waitcnt lgkmcnt(0)" ::: "memory");
      const __amdgpu_buffer_rsrc_t srdO = __builtin_amdgcn_make_buffer_rsrc((void*)Ob, 0, 0x7fffffff, 0x00020000);
      int tz = lane; asm volatile("" : "+v"(tz));
      const unsigned rb = (unsigned)(uintptr_t)stg + (unsigned)((tz >> 5) * 512 + (tz & 31) * 16);
      const int gb = ((grp * QBLK + (tz >> 5)) * LDO + (tz & 31) * 8) * 2;
      if (cmap == 0) {
#pragma unroll
        for (int i = 0; i < 16; ++i) { const u32x4 v = *(const ATY_LAS u32x4*)(uintptr_t)(rb + i * 1024);
          __builtin_amdgcn_raw_buffer_store_b128(v, srdO, gb, i * (2 * LDO * 2), 0); }
      } else {
        const __amdgpu_buffer_rsrc_t srdZ = __builtin_amdgcn_make_buffer_rsrc((void*)Zb, 0, 0x7fffffff, 0x00020000), srdY = __builtin_amdgcn_make_buffer_rsrc((void*)Yb, 0, 0x7fffffff, 0x00020000);
        const int gz = ((grp * QBLK + (tz >> 5)) * LDZ + (tz & 31) * 8) * 2;
        float g8[8];
        { const float* gp = subg + (tz & 31) * 8;
#pragma unroll
          for (int e = 0; e < 8; ++e) g8[e] = gp[e] * oscale; }
#pragma unroll 2
        for (int i = 0; i < 16; ++i) {
          const u32x4 v1 = *(const ATY_LAS u32x4*)(uintptr_t)(rb + i * 1024);
          const u32x4 v0 = __builtin_amdgcn_raw_buffer_load_b128(srdO, gb, i * (2 * LDO * 2), 16);
          const u32x4 vz = __builtin_amdgcn_raw_buffer_load_b128(srdZ, gz, i * (2 * LDZ * 2), 0);
          float o[8]; float ss = 0.f;
#pragma unroll
          for (int e = 0; e < 4; ++e) { const float a0 = __uint_as_float(v0[e] << 16), a1 = __uint_as_float(v0[e] & 0xffff0000u), b0 = __uint_as_float(v1[e] << 16), b1 = __uint_as_float(v1[e] & 0xffff0000u);
            o[2 * e] = a0 - lam * b0; o[2 * e + 1] = a1 - lam * b1; ss += o[2 * e] * o[2 * e] + o[2 * e + 1] * o[2 * e + 1]; }
#pragma unroll
          for (int sh = 1; sh < 32; sh <<= 1) ss += __shfl_xor(ss, sh);
          const float rstd = 1.0f / sqrtf(ss * (1.f / 256.f) + 1e-6f);
          u32x4 w;
#pragma unroll
          for (int e = 0; e < 4; ++e) { const float z0 = __uint_as_float(vz[e] << 16), z1 = __uint_as_float(vz[e] & 0xffff0000u);
            const float y0 = o[2 * e] * rstd * g8[2 * e] * (z0 * __builtin_amdgcn_rcpf(1.0f + __builtin_amdgcn_exp2f(-1.4426950408889634f * z0)));
            const float y1 = o[2 * e + 1] * rstd * g8[2 * e + 1] * (z1 * __builtin_amdgcn_rcpf(1.0f + __builtin_amdgcn_exp2f(-1.4426950408889634f * z1)));
            w[e] = cvtpk(y0, y1); }
          __builtin_amdgcn_raw_buffer_store_b128(w, srdY, gz, i * (2 * LDZ * 2), 0); }
      } }
  }
#undef DMA_K
#undef DMA_V
#undef DMA_K1
#undef DMA_V1
#undef WAITV_BAR
}
#undef SBAR
}

constexpr int NWAVES = 8;
constexpr int S_ = 8192, DM = 4096, PW = 8192, PG = 2048, AW = 4096, NH = 16, DH = 128;
constexpr int P4K = 4096 + 64, P8K = 8192 + 64, P2K = 2048 + 64;
constexpr float EPS = 1e-6f;
constexpr float LAM_INIT = 0.35550906759096934f;

constexpr size_t MiB = 1u << 20;
constexpr size_t WS_CTL = 0, CTL_ZERO_BYTES = 1 * MiB;
constexpr size_t WS_ADA = 1 * MiB;
constexpr size_t WS_COS = 2 * MiB, WS_SIN = 4 * MiB;
constexpr size_t WS_W_IN = 8 * MiB;
constexpr size_t WS_W_GRP = 138 * MiB;
constexpr size_t WS_W_OUTA = 171 * MiB;
constexpr size_t WS_W_KVQG = 236 * MiB;
constexpr size_t WS_W_OUTB = 366 * MiB;
constexpr size_t WS_H1 = 399 * MiB;
constexpr size_t WS_HN = 527 * MiB;
constexpr size_t WS_UZ = 592 * MiB;
constexpr size_t WS_W_INU = 848 * MiB;
constexpr size_t WS_Y = 977 * MiB;
constexpr size_t WS_KVN = 527 * MiB;
constexpr size_t WS_HNB = 592 * MiB;
constexpr size_t WS_K = 657 * MiB, WS_V = 722 * MiB, WS_Q = 787 * MiB, WS_Z = 852 * MiB;
constexpr size_t WS_OC = 917 * MiB;
constexpr size_t WS_YB = 1045 * MiB;
constexpr size_t WS_END = 1110 * MiB;
static_assert((size_t)S_ * P4K * 2 == 65 * MiB && (size_t)S_ * P8K * 2 == 129 * MiB && (size_t)4 * PG * P2K * 2 == 33 * MiB, "padded buffer sizes");
constexpr int CW_BAR = 4096;

constexpr int RING_OFF = 0;
constexpr int LDSCTL_OFF = 143360, MISC_OFF = LDSCTL_OFF + 320;
constexpr int LDS_BYTES = 147456;

#define GAS __attribute__((address_space(1)))
#define LAS __attribute__((address_space(3)))
typedef unsigned short bf16;
typedef unsigned v4u __attribute__((ext_vector_type(4)));
typedef unsigned v2u __attribute__((ext_vector_type(2)));
typedef float f32x4 __attribute__((ext_vector_type(4)));
typedef GAS unsigned gu32;
#define RLX_AGENT __ATOMIC_RELAXED, __HIP_MEMORY_SCOPE_AGENT
#define LDS_WAIT() asm volatile("s_waitcnt lgkmcnt(0)" ::: "memory")
#define VM_WAIT() asm volatile("s_waitcnt vmcnt(0)" ::: "memory")
__device__ __forceinline__ unsigned pk2(float lo, float hi) { return pg8::cvt_pk_bf16(lo, hi); }

#define XB_TMO      128
#define XB_XCNT(j)  (256  + 64 * (j))
#define XB_XSUB(j)  (1280 + 64 * (j))
#define XB_XGEN(j)  (2304 + 64 * (j))
#define XB_TOP      3328
#define XB_TOPGEN   3392
#define XCD_BAR_WORDS 3456
#define XB_SPIN_CAP (1u << 18)

__device__ __forceinline__ unsigned xb_ld(unsigned* p)              { return __hip_atomic_load(p, __ATOMIC_RELAXED, __HIP_MEMORY_SCOPE_AGENT); }
__device__ __forceinline__ unsigned xb_add(unsigned* p, unsigned v) { return __hip_atomic_fetch_add(p, v, __ATOMIC_RELAXED, __HIP_MEMORY_SCOPE_AGENT); }
__device__ __forceinline__ unsigned xb_xcc_id() { return (unsigned)__builtin_amdgcn_s_getreg((3 << 11) | 20) & 0xFu; }
#define XB_SPIN(cond, bar) do { unsigned _sp = 0; while (cond) { __builtin_amdgcn_s_sleep(1); \
    if ((++_sp & 255u) == 0u) { if (xb_ld(&(bar)[XB_TMO])) break; if (_sp > XB_SPIN_CAP) { atomicAdd(&(bar)[XB_TMO], 1u); break; } } } } while (0)

struct XcdBarrier { unsigned* bar; unsigned x; volatile LAS unsigned* st; };

__device__ __forceinline__ XcdBarrier xcd_barrier_post(unsigned* bar, volatile LAS unsigned* st) {
    XcdBarrier b; b.bar = bar; b.x = xb_xcc_id(); b.st = st;
    if (threadIdx.x == 0) (void)xb_add(&bar[XB_XCNT(b.x)], 1u);
    return b;
}
__device__ __forceinline__ void xcd_barrier_complete(unsigned* bar, unsigned x, unsigned& nloc, unsigned& nx) {
    const unsigned G = gridDim.x * gridDim.y * gridDim.z;
    unsigned sum, cnt, mine, sp = 0u;
    for (;;) {
        sum = 0u; cnt = 0u; mine = 0u;
#pragma unroll
        for (unsigned j = 0; j < 16; ++j) { const unsigned c = xb_ld(&bar[XB_XCNT(j)]); sum += c; cnt += (c > 0u) ? 1u : 0u; mine = (j == x) ? c : mine; }
        if (sum == G) break;
        __builtin_amdgcn_s_sleep(1);
        if ((++sp & 255u) == 0u) { if (xb_ld(&bar[XB_TMO])) break; if (sp > XB_SPIN_CAP) { atomicAdd(&bar[XB_TMO], 1u); break; } }
    }
    nloc = mine > 0u ? mine : 1u; nx = cnt > 0u ? cnt : 1u;
}
__device__ __forceinline__ void xcd_barrier(const XcdBarrier& b) {
    asm volatile("s_waitcnt vmcnt(0)" ::: "memory");
    __syncthreads();
    if (threadIdx.x == 0) {
        unsigned* bar = b.bar;
        __builtin_amdgcn_s_waitcnt(0);
        unsigned nloc = b.st[0], nx = b.st[1];
        if (nloc == 0u) { xcd_barrier_complete(bar, b.x, nloc, nx); b.st[0] = nloc; b.st[1] = nx; }
        const unsigned old = xb_add(&bar[XB_XSUB(b.x)], 1u);
        const unsigned gen = old / nloc;
        if (old + 1u == (gen + 1u) * nloc) {
            __builtin_amdgcn_fence(__ATOMIC_RELEASE, "agent");
            asm volatile("s_waitcnt vmcnt(0)" ::: "memory");
            const unsigned og = xb_add(&bar[XB_TOP], 1u);
            const unsigned tg = og / nx;
            if (og + 1u == (tg + 1u) * nx) xb_add(&bar[XB_TOPGEN], 1u);
            else XB_SPIN(xb_ld(&bar[XB_TOPGEN]) == tg, bar);
            __builtin_amdgcn_fence(__ATOMIC_ACQUIRE, "agent");
            xb_add(&bar[XB_XGEN(b.x)], 1u);
            asm volatile("s_waitcnt vmcnt(0)" ::: "memory");
        } else {
            XB_SPIN(xb_ld(&bar[XB_XGEN(b.x)]) == gen, bar);
            __builtin_amdgcn_fence(__ATOMIC_ACQUIRE, "agent");
            asm volatile("s_waitcnt vmcnt(0)" ::: "memory");
        }
    }
    __syncthreads();
}

struct Frame {
    LAS unsigned char* lds;
    volatile LAS unsigned* MISC;
    gu32* ctl;
    int tid, lane, wave;
    int vcu, G;
};
struct Args {
    const float* x; const float* c; const int* pos;
    const float* a_norm_g; const float* a_ada_w; const float* a_ada_b; const float* a_w_in; const float* a_w_group; const float* a_scale; const float* a_w_out;
    const float* kv_norm_g; const float* kv_ada_w; const float* kv_ada_b; const float* w_kv;
    const float* b_norm_g; const float* b_ada_w; const float* b_ada_b; const float* b_w_qg; const float* b_lam; const float* b_subln_g; const float* b_w_out; const float* final_g;
    float* out; unsigned char* ws; int ph_lo, ph_hi, li, pad;
};

__device__ __forceinline__ float wave_sum(float v) {
#pragma unroll
    for (int o = 1; o < 64; o <<= 1) v += __shfl_xor(v, o);
    return v;
}
__device__ __forceinline__ float half_sum(float v) {
#pragma unroll
    for (int o = 1; o < 32; o <<= 1) v += __shfl_xor(v, o);
    return v;
}

__device__ __forceinline__ void p0_ada(Frame& F, const Args& a) {
    LAS float* sc = (LAS float*)(F.lds + RING_OFF);
    LAS float* part = sc + 4096;
    for (int k = F.tid; k < DM; k += NWAVES * 64) { const float c = a.c[k]; sc[k] = pg8::silu_f(c); }
    __syncthreads();
    float* mall = (float*)(a.ws + WS_ADA);
    const int cg = F.lane & 31, kp = F.lane >> 5;
    for (int slab = blockIdx.x; slab < 256; slab += F.G) {
        const int j0 = slab * 128;
        const float* W; const float* bias; int N, c0;
        if (j0 < 12288) { W = a.a_ada_w; bias = a.a_ada_b; N = 12288; c0 = j0; }
        else if (j0 < 20480) { W = a.kv_ada_w; bias = a.kv_ada_b; N = 8192; c0 = j0 - 12288; }
        else { W = a.b_ada_w; bias = a.b_ada_b; N = 12288; c0 = j0 - 20480; }
        const float* wp = W + (size_t)(512 * F.wave + kp) * N + c0 + 4 * cg;
        const LAS float* sp = sc + 512 * F.wave + kp;
        f32x4 acc = (f32x4){0.f, 0.f, 0.f, 0.f};
#pragma unroll 16
        for (int i = 0; i < 256; ++i) { const f32x4 wv = *(const GAS f32x4*)(wp + (size_t)(2 * i) * N); acc += sp[2 * i] * wv; }
#pragma unroll
        for (int e = 0; e < 4; ++e) acc[e] += __shfl_xor(acc[e], 32);
        if (kp == 0) { LAS float* pp = part + F.wave * 128 + 4 * cg; pp[0] = acc[0]; pp[1] = acc[1]; pp[2] = acc[2]; pp[3] = acc[3]; }
        __syncthreads();
        if (F.tid < 128) { float s = bias[c0 + F.tid];
#pragma unroll
            for (int w = 0; w < 8; ++w) s += part[w * 128 + F.tid];
            mall[j0 + F.tid] = s; }
        __syncthreads();
    }
}
__device__ __forceinline__ void p0_rope(Frame& F, const Args& a) {
    float* cs = (float*)(a.ws + WS_COS); float* sn = (float*)(a.ws + WS_SIN);
    const int gt = blockIdx.x * (NWAVES * 64) + F.tid, NT = F.G * NWAVES * 64;
    for (int idx = gt; idx < S_ * 64; idx += NT) {
        const int row = idx >> 6, i = idx & 63;
        double inv = 1.0, b = 0.8659643233600653; int e = i;
        while (e) { if (e & 1) inv *= b; b *= b; e >>= 1; }
        const double ang = (double)a.pos[row] * inv;
        const double kq = rint(ang * 0.63661977236758134308);
        double r = fma(-kq, 1.5707963267948966, ang); r = fma(-kq, 6.123233995736766e-17, r);
        const double r2 = r * r;
        double sp = -7.6471637318198164759e-13; sp = fma(sp, r2, 1.6059043836821614599e-10); sp = fma(sp, r2, -2.5052108385441718775e-8); sp = fma(sp, r2, 2.7557319223985890653e-6);
        sp = fma(sp, r2, -1.9841269841269841270e-4); sp = fma(sp, r2, 8.3333333333333333333e-3); sp = fma(sp, r2, -1.6666666666666666667e-1); sp = fma(sp * r2, r, r);
        double cp = 4.7794773323873852974e-14; cp = fma(cp, r2, -1.1470745597729724714e-11); cp = fma(cp, r2, 2.0876756987868098979e-9); cp = fma(cp, r2, -2.7557319223985890653e-7);
        cp = fma(cp, r2, 2.4801587301587301587e-5); cp = fma(cp, r2, -1.3888888888888888889e-3); cp = fma(cp, r2, 4.1666666666666666667e-2); cp = fma(cp, r2, -0.5); cp = fma(cp, r2, 1.0);
        const int q = ((int)kq) & 3;
        const double sv = (q == 0) ? sp : (q == 1) ? cp : (q == 2) ? -sp : -cp;
        const double cv = (q == 0) ? cp : (q == 1) ? -sp : (q == 2) ? -cp : sp;
        cs[idx] = (float)cv; sn[idx] = (float)sv;
    }
}
template <bool ROPE>
__device__ __forceinline__ void p0_transpose_item(const float* W, int K, int N, int ldw, bf16* WT, int ldt, int row_off, LAS float* scr, int item, int lane) {
    const int nblk = N / 64, kb = item / nblk, nb = item % nblk, k0 = 64 * kb, n0 = 64 * nb;
    f32x4 v[16];
    const float* wp = W + (size_t)(k0 + (lane >> 4)) * ldw + n0 + 4 * (lane & 15);
#pragma unroll
    for (int i = 0; i < 16; ++i) v[i] = *(const GAS f32x4*)(wp + (size_t)(4 * i) * ldw);
#pragma unroll
    for (int i = 0; i < 16; ++i) { LAS float* s = scr + (4 * i + (lane >> 4)) * 65 + 4 * (lane & 15); s[0] = v[i][0]; s[1] = v[i][1]; s[2] = v[i][2]; s[3] = v[i][3]; }
    LDS_WAIT(); asm volatile("" ::: "memory");
    const int c = lane & 7;
#pragma unroll
    for (int j = 0; j < 8; ++j) { const int n = (lane >> 3) + 8 * j; const LAS float* s = scr + (8 * c) * 65 + n;
        v4u o; o.x = pk2(s[0 * 65], s[1 * 65]); o.y = pk2(s[2 * 65], s[3 * 65]); o.z = pk2(s[4 * 65], s[5 * 65]); o.w = pk2(s[6 * 65], s[7 * 65]);
        int ng = n0 + n;
        if (ROPE && ng < 4096) { const int p = ng & 127; ng = (ng & ~127) + ((p < 64) ? 2 * p : 2 * (p - 64) + 1); }
        *(GAS v4u*)(WT + (size_t)(row_off + ng) * ldt + k0 + 8 * c) = o; }
    LDS_WAIT(); asm volatile("" ::: "memory");
}
__device__ __forceinline__ void p0_copy_item(const float* W, int ldw, bf16* O, int ldo, int item, int lane) {
    const int row = item >> 3, seg = item & 7;
    const GAS f32x4* wp = (const GAS f32x4*)(W + (size_t)row * ldw + seg * 1024 + lane * 16);
    const f32x4 a = wp[0], b = wp[1], c = wp[2], d = wp[3];
    GAS v4u* op = (GAS v4u*)(O + (size_t)row * ldo + seg * 1024 + lane * 16);
    v4u o0, o1; o0.x = pk2(a.x, a.y); o0.y = pk2(a.z, a.w); o0.z = pk2(b.x, b.y); o0.w = pk2(b.z, b.w); o1.x = pk2(c.x, c.y); o1.y = pk2(c.z, c.w); o1.z = pk2(d.x, d.y); o1.w = pk2(d.z, d.w);
    op[0] = o0; op[1] = o1;
}
__device__ __forceinline__ void p0_convert(Frame& F, const Args& a) {
    LAS float* scr = (LAS float*)(F.lds + RING_OFF) + F.wave * (64 * 65);
    const int gw = F.vcu * NWAVES + F.wave, NGW = F.G * NWAVES;
    constexpr int I_INZ = (DM / 64) * (PW / 64), I_GRP = (PG / 64) * (PG / 64), I_OA = (PW / 64) * (DM / 64), I_KV = (DM / 64) * (2 * AW / 64), I_OB = (AW / 64) * (DM / 64);
    constexpr int I_INU = DM * 8;
    constexpr int NITEMS = I_INZ + 4 * I_GRP + I_OA + 2 * I_KV + I_OB;
    unsigned char* ws = a.ws;
    for (int it = gw; it < I_INU; it += NGW) p0_copy_item(a.a_w_in, 2 * PW, (bf16*)(ws + WS_W_INU), P8K, it, F.lane);
    for (int it = gw; it < NITEMS; it += NGW) {
        int r = it;
        if (r < 4 * I_GRP) { const int g = r / I_GRP; p0_transpose_item<false>(a.a_w_group + (size_t)g * PG * PG, PG, PG, PG, (bf16*)(ws + WS_W_GRP), P2K, g * PG, scr, r % I_GRP, F.lane); continue; } r -= 4 * I_GRP;
        if (r < I_INZ) { p0_transpose_item<false>(a.a_w_in + PW, DM, PW, 2 * PW, (bf16*)(ws + WS_W_IN), P4K, PW, scr, r, F.lane); continue; } r -= I_INZ;
        if (r < I_OA) { p0_transpose_item<false>(a.a_w_out, PW, DM, DM, (bf16*)(ws + WS_W_OUTA), P8K, 0, scr, r, F.lane); continue; } r -= I_OA;
        if (r < I_KV) { p0_transpose_item<true>(a.w_kv, DM, 2 * AW, 2 * AW, (bf16*)(ws + WS_W_KVQG), P4K, 0, scr, r, F.lane); continue; } r -= I_KV;
        if (r < I_KV) { p0_transpose_item<true>(a.b_w_qg, DM, 2 * AW, 2 * AW, (bf16*)(ws + WS_W_KVQG), P4K, 2 * AW, scr, r, F.lane); continue; } r -= I_KV;
        p0_transpose_item<false>(a.b_w_out, AW, DM, DM, (bf16*)(ws + WS_W_OUTB), P4K, 0, scr, r, F.lane);
    }
}
template <int NOUT>
__device__ __forceinline__ void norm_mod_rows(Frame& F, const float* xin, bf16* out0, bf16* out1, const LAS float* tab) {
    const int gw = F.vcu * NWAVES + F.wave, NGW = F.G * NWAVES;
    for (int m = gw; m < S_; m += NGW) {
        const GAS f32x4* xr = (const GAS f32x4*)(xin + (size_t)m * DM) + F.lane;
        f32x4 v[16]; float s = 0.f;
#pragma unroll
        for (int j = 0; j < 16; ++j) { v[j] = xr[64 * j]; s += (v[j].x * v[j].x + v[j].y * v[j].y) + (v[j].z * v[j].z + v[j].w * v[j].w); }
        const float rstd = 1.0f / sqrtf(wave_sum(s) * (1.f / DM) + EPS);
#pragma unroll
        for (int o = 0; o < NOUT; ++o) {
            GAS v2u* op = (GAS v2u*)((o == 0 ? out0 : out1) + (size_t)m * P4K) + F.lane;
            const LAS f32x4* gs = (const LAS f32x4*)(tab + o * 2 * DM) + F.lane; const LAS f32x4* sh = (const LAS f32x4*)(tab + o * 2 * DM + DM) + F.lane;
#pragma unroll
            for (int j = 0; j < 16; ++j) { const f32x4 g = gs[64 * j], h = sh[64 * j]; const f32x4 y = v[j] * rstd * g + h;
                v2u w; w.x = pk2(y.x, y.y); w.y = pk2(y.z, y.w); op[64 * j] = w; }
        }
    }
}
__device__ __forceinline__ void unpack8(const v4u u, float* f) {
    f[0] = pg8::bf_lo(u.x); f[1] = pg8::bf_hi(u.x); f[2] = pg8::bf_lo(u.y); f[3] = pg8::bf_hi(u.y); f[4] = pg8::bf_lo(u.z); f[5] = pg8::bf_hi(u.z); f[6] = pg8::bf_lo(u.w); f[7] = pg8::bf_hi(u.w);
}
__device__ __forceinline__ void p3_pool(Frame& F, const Args& a) {
    const bf16* __restrict__ U = (const bf16*)(a.ws + WS_UZ); bf16* __restrict__ P = (bf16*)(a.ws + WS_Y);
    const int gt = F.vcu * (NWAVES * 64) + F.tid, NT = F.G * NWAVES * 64;
    constexpr int RB = 32, NCH = PW / 8, NITEM = (S_ / RB) * NCH, LDU = 2 * PW;
    for (int it = gt; it < NITEM; it += NT) {
        const int ch = it % NCH, rb = it / NCH, t0 = rb * RB, w = 2 << (ch >> 8);
        const bf16* up = U + (size_t)ch * 8; bf16* pp = P + (size_t)ch * 8;
        float sc[8];
        { const f32x4 s0 = *(const GAS f32x4*)(a.a_scale + ch * 8), s1 = *(const GAS f32x4*)(a.a_scale + ch * 8 + 4);
          sc[0] = s0.x; sc[1] = s0.y; sc[2] = s0.z; sc[3] = s0.w; sc[4] = s1.x; sc[5] = s1.y; sc[6] = s1.z; sc[7] = s1.w; }
        float sum[8]; float f[8], z[8];
#pragma unroll
        for (int e = 0; e < 8; ++e) sum[e] = 0.f;
        for (int j = 1; j < w; ++j) { const int t = t0 - j; if (t >= 0) { unpack8(*(const GAS v4u*)(up + (size_t)t * LDU), f);
#pragma unroll
            for (int e = 0; e < 8; ++e) sum[e] += f[e]; } }
#pragma unroll 1
        for (int tb = t0; tb < t0 + RB; tb += 8) {
            v4u vv[8], vz[8], vo[8];
#pragma unroll
            for (int r = 0; r < 8; ++r) { const int t = tb + r, tl = t - w + 1;
                vv[r] = *(const GAS v4u*)(up + (size_t)t * LDU); vz[r] = *(const GAS v4u*)(up + (size_t)t * LDU + PW);
                vo[r] = *(const GAS v4u*)(up + (size_t)(tl >= 0 ? tl : 0) * LDU); }
#pragma unroll
            for (int r = 0; r < 8; ++r) { const int t = tb + r, tl = t - w + 1;
                unpack8(vv[r], f); unpack8(vz[r], z);
                const float rc = 1.0f / (float)((t + 1 < w) ? (t + 1) : w);
                float o[8];
#pragma unroll
                for (int e = 0; e < 8; ++e) { sum[e] += f[e]; o[e] = (sum[e] * rc - f[e]) * sc[e] * pg8::silu_f(z[e]); }
                v4u ov; ov.x = pk2(o[0], o[1]); ov.y = pk2(o[2], o[3]); ov.z = pk2(o[4], o[5]); ov.w = pk2(o[6], o[7]);
                *(GAS v4u*)(pp + (size_t)t * P8K) = ov;
                if (tl >= 0) { unpack8(vo[r], f);
#pragma unroll
                    for (int e = 0; e < 8; ++e) sum[e] -= f[e]; } }
        }
    }
}
__device__ __forceinline__ void p9_combine(Frame& F, const Args& a) {
    float d1 = 0.f, d2 = 0.f;
    for (int i = F.lane; i < DH; i += 64) { d1 += a.b_lam[i] * a.b_lam[DH + i]; d2 += a.b_lam[2 * DH + i] * a.b_lam[3 * DH + i]; }
    d1 = wave_sum(d1); d2 = wave_sum(d2);
    const float lam = expf(d1) - expf(d2) + LAM_INIT;
    const bf16* OC = (const bf16*)(a.ws + WS_OC); const bf16* Z = (const bf16*)(a.ws + WS_Z); bf16* YB = (bf16*)(a.ws + WS_YB);
    const int gw = F.vcu * NWAVES + F.wave, NGW = F.G * NWAVES;
    float g8[8];
    { const float* gp = a.b_subln_g + 8 * (F.lane & 31);
#pragma unroll
      for (int e = 0; e < 8; ++e) g8[e] = gp[e] * (1.0f - LAM_INIT); }
    for (int m = gw; m < S_; m += NGW) {
        const GAS v4u* o0p = (const GAS v4u*)(OC + (size_t)m * (2 * AW)) + F.lane; const GAS v4u* o1p = (const GAS v4u*)(OC + (size_t)m * (2 * AW) + AW) + F.lane;
        const GAS v4u* zp = (const GAS v4u*)(Z + (size_t)m * P4K) + F.lane; GAS v4u* yp = (GAS v4u*)(YB + (size_t)m * P4K) + F.lane;
#pragma unroll 2
        for (int j = 0; j < 8; ++j) {
            float f0[8], f1[8], fz[8], o[8];
            unpack8(o0p[64 * j], f0); unpack8(o1p[64 * j], f1); unpack8(zp[64 * j], fz);
            float ss = 0.f;
#pragma unroll
            for (int e = 0; e < 8; ++e) { o[e] = f0[e] - lam * f1[e]; ss += o[e] * o[e]; }
            const float rstd = 1.0f / sqrtf(half_sum(ss) * (1.f / 256.f) + EPS);
#pragma unroll
            for (int e = 0; e < 8; ++e) o[e] = o[e] * rstd * g8[e] * pg8::silu_f(fz[e]);
            v4u ov; ov.x = pk2(o[0], o[1]); ov.y = pk2(o[2], o[3]); ov.z = pk2(o[4], o[5]); ov.w = pk2(o[6], o[7]);
            yp[64 * j] = ov;
        }
    }
}
__device__ __forceinline__ void p11_final(Frame& F, const Args& a) {
    const int gw = F.vcu * NWAVES + F.wave, NGW = F.G * NWAVES;
    for (int m = gw; m < S_; m += NGW) {
        GAS f32x4* xr = (GAS f32x4*)(a.out + (size_t)m * DM) + F.lane; const GAS f32x4* gp = (const GAS f32x4*)a.final_g + F.lane;
        f32x4 v[16]; float s = 0.f;
#pragma unroll
        for (int j = 0; j < 16; ++j) { v[j] = xr[64 * j]; s += (v[j].x * v[j].x + v[j].y * v[j].y) + (v[j].z * v[j].z + v[j].w * v[j].w); }
        const float rstd = 1.0f / sqrtf(wave_sum(s) * (1.f / DM) + EPS);
#pragma unroll
        for (int j = 0; j < 16; ++j) xr[64 * j] = v[j] * rstd * gp[64 * j];
    }
}

__global__ void __launch_bounds__(NWAVES * 64, 2) yoco_fwd(Args args) {
    extern __shared__ __attribute__((aligned(16))) unsigned char lds[];
    Frame F;
    F.lds = (LAS unsigned char*)lds;
    F.MISC = (volatile LAS unsigned*)(F.lds + MISC_OFF);
    F.tid = threadIdx.x; F.lane = F.tid & 63; F.wave = __builtin_amdgcn_readfirstlane(F.tid >> 6);
    F.G = gridDim.x; { const int bx = blockIdx.x; F.vcu = (F.G % 8 == 0) ? (bx % 8) * (F.G / 8) + bx / 8 : bx; }
    unsigned char* ws = args.ws;
    F.ctl = (gu32*)(ws + WS_CTL);
    for (int u = F.tid; u < (LDS_BYTES - LDSCTL_OFF) / 4; u += NWAVES * 64) ((LAS unsigned*)(F.lds + LDSCTL_OFF))[u] = 0u;
    __syncthreads();
    XcdBarrier bar; bar.bar = (unsigned*)(F.ctl + CW_BAR); bar.x = 0; bar.st = nullptr;
    if (N_LAUNCHES == 1) bar = xcd_barrier_post((unsigned*)(F.ctl + CW_BAR), F.MISC + 8);
#define GRID_BAR() do { if (N_LAUNCHES == 1) xcd_barrier(bar); } while (0)
    const int lo = args.ph_lo, hi = args.ph_hi;
#define IN(k) (lo <= (k) && (k) < hi)
#define BOTH(k) (IN(k) && IN((k) + 1))
    const float* mall = (const float*)(ws + WS_ADA);
#ifdef CLOCK_PROBE
    unsigned long long ck_t0 = 0, ck_r0 = 0, ck_t1 = 1, ck_r1 = 1;
#define CK_BEGIN(k) do { if (CLOCK_PROBE == (k)) { ck_t0 = __builtin_amdgcn_s_memtime(); ck_r0 = __builtin_amdgcn_s_memrealtime(); } } while (0)
#define CK_END(k) do { if (CLOCK_PROBE == (k)) { ck_t1 = __builtin_amdgcn_s_memtime(); ck_r1 = __builtin_amdgcn_s_memrealtime(); } } while (0)
#else
#define CK_BEGIN(k) do {} while (0)
#define CK_END(k) do {} while (0)
#endif

    if (IN(0)) { p0_ada(F, args); p0_rope(F, args); p0_convert(F, args);
        if (PROBE_DUP == 0) { __syncthreads(); p0_ada(F, args); p0_rope(F, args); p0_convert(F, args); }
        if (BOTH(0)) GRID_BAR(); }

    if (IN(1)) {
        LAS float* tab = (LAS float*)(F.lds + RING_OFF);
        for (int c = F.tid; c < DM; c += NWAVES * 64) { tab[c] = args.a_norm_g[c] * (1.0f + mall[DM + c]); tab[DM + c] = mall[c]; }
        __syncthreads();
        norm_mod_rows<1>(F, args.x, (bf16*)(ws + WS_HN), nullptr, tab);
        if (PROBE_DUP == 1) norm_mod_rows<1>(F, args.x, (bf16*)(ws + WS_HN), nullptr, tab);
        __syncthreads();
        { pg8::Gemm g{(const pg8::bf16_t*)(ws + WS_W_GRP), (const pg8::bf16_t*)(ws + WS_W_INU), PW, DM, PG, P2K, P8K, 1 << 20, 0, 8, (long)PG * 2};
          pg8::StaticOrder S; S.init(PW, DM, F.G, (int)blockIdx.x);
          pg8::EpiBf16 E{(pg8::bf16_t*)(ws + WS_W_IN), P4K};
          pg8::gemm_phase<pg8::EpiBf16, pg8::StaticOrder, true, true>(F.lds + RING_OFF, g, S, E); }
        if (BOTH(1)) GRID_BAR();
    }
    if (IN(2)) {
        pg8::Gemm g{(const pg8::bf16_t*)(ws + WS_HN), (const pg8::bf16_t*)(ws + WS_W_IN), S_, 2 * PW, DM, P4K, P4K, 1 << 20, 0, 1 << 20, 0};
        pg8::StaticOrder S; S.init(S_, 2 * PW, F.G, (int)blockIdx.x);
        pg8::EpiBf16 E{(pg8::bf16_t*)(ws + WS_UZ), 2 * PW};
        CK_BEGIN(2);
        pg8::gemm_phase<pg8::EpiBf16, pg8::StaticOrder, true, true>(F.lds + RING_OFF, g, S, E);
        CK_END(2);
        if (PROBE_DUP == 2) { __syncthreads(); pg8::gemm_phase<pg8::EpiBf16, pg8::StaticOrder, true, true>(F.lds + RING_OFF, g, S, E); }
        if (PROBE_DUP == 202) { __syncthreads(); pg8::EpiNull EN; pg8::SameTileOrder S2; S2.init(S_, 2 * PW, F.G, (int)blockIdx.x); pg8::gemm_phase<pg8::EpiNull, pg8::SameTileOrder, true, true>(F.lds + RING_OFF, g, S2, EN); }
        if (PROBE_DUP == 102) { __syncthreads(); pg8::EpiNull EN; pg8::gemm_phase<pg8::EpiNull, pg8::StaticOrder, true, true>(F.lds + RING_OFF, g, S, EN); }
        if (BOTH(2)) GRID_BAR();
    }
    if (IN(3)) { p3_pool(F, args); if (PROBE_DUP == 3) p3_pool(F, args); if (BOTH(3)) GRID_BAR(); }
    if (IN(5)) {
        pg8::Gemm g{(const pg8::bf16_t*)(ws + WS_Y), (const pg8::bf16_t*)(ws + WS_W_OUTA), S_, DM, PW, P8K, P8K, 1 << 20, 0, 1 << 20, 0};
        pg8::StaticOrder S; S.init(S_, DM, F.G, (int)blockIdx.x);
        pg8::EpiResid E{args.x, (float*)(ws + WS_H1), DM, mall + 2 * DM};
        pg8::gemm_phase<pg8::EpiResid, pg8::StaticOrder, true, true>(F.lds + RING_OFF, g, S, E);
        if (BOTH(5)) GRID_BAR();
    }
    if (IN(6)) {
        LAS float* tab = (LAS float*)(F.lds + RING_OFF);
        const float* mkv = mall + 12288; const float* mb = mall + 20480;
        for (int c = F.tid; c < DM; c += NWAVES * 64) {
            tab[c] = args.kv_norm_g[c] * (1.0f + mkv[DM + c]); tab[DM + c] = mkv[c];
            tab[2 * DM + c] = args.b_norm_g[c] * (1.0f + mb[DM + c]); tab[3 * DM + c] = mb[c]; }
        __syncthreads();
        norm_mod_rows<2>(F, (const float*)(ws + WS_H1), (bf16*)(ws + WS_KVN), (bf16*)(ws + WS_HNB), tab);
        if (PROBE_DUP == 6) norm_mod_rows<2>(F, (const float*)(ws + WS_H1), (bf16*)(ws + WS_KVN), (bf16*)(ws + WS_HNB), tab);
        if (BOTH(6)) GRID_BAR();
    }
    if (IN(7)) {
        pg8::Gemm g{(const pg8::bf16_t*)(ws + WS_KVN), (const pg8::bf16_t*)(ws + WS_W_KVQG), S_, 4 * AW, DM, P4K, P4K, 32, (long)(WS_HNB - WS_KVN), 1 << 20, 0};
        pg8::StaticOrder S; S.init(S_, 4 * AW, F.G, (int)blockIdx.x);
        pg8::EpiKVQZ E{(pg8::bf16_t*)(ws + WS_K), (size_t)(WS_V - WS_K) / 2, P4K, S_, (const float*)(ws + WS_COS), (const float*)(ws + WS_SIN), atty::QSCALE};
        pg8::gemm_phase<pg8::EpiKVQZ, pg8::StaticOrder, true, true>(F.lds + RING_OFF, g, S, E);
        if (BOTH(7)) GRID_BAR();
    }
    if (IN(8)) {
        static_assert(atty::LDS_END <= LDSCTL_OFF && atty::LDZ == P4K, "attention LDS / pitches");
        const atty::bf16* Q = (const atty::bf16*)(ws + WS_Q); const atty::bf16* Kt = (const atty::bf16*)(ws + WS_K); const atty::bf16* V = (const atty::bf16*)(ws + WS_V); atty::bf16* OC = (atty::bf16*)(ws + WS_OC);
        const atty::bf16* Zt = (const atty::bf16*)(ws + WS_Z); atty::bf16* YB = (atty::bf16*)(ws + WS_YB);
        float lam;
        { float d1 = 0.f, d2 = 0.f;
          for (int i = F.lane; i < DH; i += 64) { d1 += args.b_lam[i] * args.b_lam[DH + i]; d2 += args.b_lam[2 * DH + i] * args.b_lam[3 * DH + i]; }
          d1 = wave_sum(d1); d2 = wave_sum(d2); lam = expf(d1) - expf(d2) + LAM_INIT; }
        const int ncombo = 16 * 32;
        CK_BEGIN(8);
#pragma unroll 1
        for (int pi = F.vcu; pi < ncombo; pi += F.G) {
            const int h = pi >> 5, p = pi & 31;
#pragma unroll 1
            for (int s = 0; s < 4; ++s) {
                const int c = s & 1, qb = (s & 2) ? p : 63 - p, q0 = qb * atty::UROWS, hh = 2 * h + c;
                atty::attn_unit<0>(Q + ((size_t)hh * S_ + q0) * DH, Kt + (size_t)hh * S_ * DH, V + (size_t)h * S_ * 256, OC + (size_t)q0 * AW + h * 256, c,
                                   Zt + (size_t)q0 * P4K + h * 256, YB + (size_t)q0 * P4K + h * 256, lam, args.b_subln_g, 1.0f - LAM_INIT,
                                   2 * qb + 2, 2 * qb + ((F.wave & 3) >> 1), F.lds + RING_OFF);
            }
        }
        CK_END(8);
        if (PROBE_DUP >= 800 && PROBE_DUP < 928) {
            atty::bf16* OD = (atty::bf16*)(ws + WS_END);
#pragma unroll 1
            for (int pi = F.vcu; pi < ncombo; pi += F.G) {
                const int h = pi >> 5, p = pi & 31;
#pragma unroll 1
                for (int s = 0; s < 4; ++s) {
                    const int c = s & 1, qb = (s & 2) ? p : 63 - p, q0 = qb * atty::UROWS, hh = 2 * h + c;
                    atty::attn_unit<(PROBE_DUP >= 800 && PROBE_DUP < 928) ? PROBE_DUP - 800 : 0>(Q + ((size_t)hh * S_ + q0) * DH, Kt + (size_t)hh * S_ * DH, V + (size_t)h * S_ * 256, OD + (size_t)q0 * AW + h * 256, 0,
                                       Zt, OD, lam, args.b_subln_g, 1.0f, 2 * qb + 2, 2 * qb + ((F.wave & 3) >> 1), F.lds + RING_OFF);
                }
            }
        }
        __syncthreads();
        if (BOTH(8)) GRID_BAR();
    }
    if (IN(10)) {
        pg8::Gemm g{(const pg8::bf16_t*)(ws + WS_YB), (const pg8::bf16_t*)(ws + WS_W_OUTB), S_, DM, AW, P4K, P4K, 1 << 20, 0, 1 << 20, 0};
        pg8::StaticOrder S; S.init(S_, DM, F.G, (int)blockIdx.x);
        pg8::EpiResid E{(const float*)(ws + WS_H1), args.out, DM, mall + 20480 + 2 * DM};
        pg8::gemm_phase<pg8::EpiResid, pg8::StaticOrder, true, true>(F.lds + RING_OFF, g, S, E);
        if (BOTH(10)) GRID_BAR();
    }
    if (IN(11)) { p11_final(F, args); }
#ifdef CLOCK_PROBE
    __syncthreads();
    if (blockIdx.x == 0 && F.tid == 0) { VM_WAIT(); args.out[0] = 100.0f * rintf((float)((double)(ck_t1 - ck_t0) / (double)(ck_r1 - ck_r0))); }
#endif
#undef IN
#undef BOTH
#undef GRID_BAR
}

extern "C" void kernel_launch(void* const* d_in, const int* in_sizes, int n_in, void* d_out, int out_size, void* d_ws, size_t ws_size, hipStream_t stream) {
    static int grid = 0;
    if (grid == 0) {
        if (n_in != 22 || in_sizes[0] != S_ * DM || out_size != S_ * DM || ws_size < WS_END) {
            fprintf(stderr, "kernel_launch: shape mismatch: n_in %d in0 %d out %d ws %zu (need %zu)\n", n_in, n_in > 0 ? in_sizes[0] : -1, out_size, ws_size, (size_t)WS_END); grid = -1; return; }
        int dev = 0, cus = 0, per_cu = 0;
        if (hipGetDevice(&dev) != hipSuccess || hipDeviceGetAttribute(&cus, hipDeviceAttributeMultiprocessorCount, dev) != hipSuccess) { fprintf(stderr, "kernel_launch: device query failed\n"); grid = -1; return; }
        if (hipFuncSetAttribute((const void*)yoco_fwd, hipFuncAttributeMaxDynamicSharedMemorySize, LDS_BYTES) != hipSuccess) { fprintf(stderr, "kernel_launch: hipFuncSetAttribute failed\n"); grid = -1; return; }
        if (hipOccupancyMaxActiveBlocksPerMultiprocessor(&per_cu, (const void*)yoco_fwd, NWAVES * 64, LDS_BYTES) != hipSuccess || per_cu < 1)
            fprintf(stderr, "kernel_launch: occupancy query reports %d workgroups per CU\n", per_cu);
        (void)hipGetLastError();
        grid = cus;
    }
    if (grid < 0) return;
    if (hipMemsetAsync((char*)d_ws + WS_CTL, 0, CTL_ZERO_BYTES, stream) != hipSuccess) { fprintf(stderr, "kernel_launch: memset failed\n"); return; }
    Args a{};
    a.x = (const float*)d_in[0]; a.c = (const float*)d_in[1]; a.pos = (const int*)d_in[2];
    a.a_norm_g = (const float*)d_in[3]; a.a_ada_w = (const float*)d_in[4]; a.a_ada_b = (const float*)d_in[5]; a.a_w_in = (const float*)d_in[6]; a.a_w_group = (const float*)d_in[7];
    a.a_scale = (const float*)d_in[8]; a.a_w_out = (const float*)d_in[9];
    a.kv_norm_g = (const float*)d_in[10]; a.kv_ada_w = (const float*)d_in[11]; a.kv_ada_b = (const float*)d_in[12]; a.w_kv = (const float*)d_in[13];
    a.b_norm_g = (const float*)d_in[14]; a.b_ada_w = (const float*)d_in[15]; a.b_ada_b = (const float*)d_in[16]; a.b_w_qg = (const float*)d_in[17]; a.b_lam = (const float*)d_in[18];
    a.b_subln_g = (const float*)d_in[19]; a.b_w_out = (const float*)d_in[20]; a.final_g = (const float*)d_in[21];
    a.out = (float*)d_out; a.ws = (unsigned char*)d_ws;
    for (int li = 0; li < N_LAUNCHES; ++li) {
        a.ph_lo = (N_LAUNCHES == 1) ? 0 : li; a.ph_hi = (N_LAUNCHES == 1) ? N_PHASES : li + 1; a.li = li; a.pad = 0;
        hipLaunchKernelGGL(yoco_fwd, dim3(grid), dim3(NWAVES * 64), LDS_BYTES, stream, a);
        const hipError_t le = hipPeekAtLastError();
        if (le != hipSuccess) { fprintf(stderr, "kernel_launch: launch %d failed: %s\n", li, hipGetErrorName(le)); break; }
    }
}
```
